# Optimizing an MI355X kernel written in HIP

```python
import jax, jax.numpy as jnp
from jax import lax
import numpy as np

D_MODEL = 1024
BATCH = 8
SEQ = 4096
DEPTH = 1

D_FF = 2816
D_PLE = 256
D_GMLP = D_MODEL
N_SGU_GROUPS = 4
CHUNK = 128
D_POOL = D_MODEL
POOL_WINDOWS = (2, 4, 8, 16)
N_POOL_GROUPS = len(POOL_WINDOWS)
D_IN = 2 * D_GMLP + D_POOL + 2 * D_MODEL
EPS = 1e-6

kernel_name = "hybrid_sgu_pool_macaron_layer"


def _rmsnorm(x, g):
    xf = x.astype(jnp.float32)
    y = xf * lax.rsqrt(jnp.mean(xf * xf, axis=-1, keepdims=True) + EPS)
    return (y * g.astype(jnp.float32)).astype(x.dtype)


def _layernorm(x, g):
    xf = x.astype(jnp.float32)
    mu = jnp.mean(xf, axis=-1, keepdims=True)
    xc = xf - mu
    y = xc * lax.rsqrt(jnp.mean(xc * xc, axis=-1, keepdims=True) + EPS)
    return (y * g.astype(jnp.float32)).astype(x.dtype)


def _swiglu(xn, w_gate, w_up, w_down):
    return (jax.nn.silu(xn @ w_gate) * (xn @ w_up)) @ w_down


def _spatial_gating(u, v, norm_g, w_s, b_s):
    B, S, _ = v.shape
    dg = D_GMLP // N_SGU_GROUPS
    v = _layernorm(v, norm_g)
    vc = v.reshape(B, S // CHUNK, CHUNK, N_SGU_GROUPS, dg)
    causal = jnp.tril(jnp.ones((CHUNK, CHUNK), dtype=bool))
    ws = jnp.where(causal[None], w_s, 0.0).astype(v.dtype)
    sv = jnp.einsum('gts,bcsgd->bctgd', ws, vc) + b_s.T[:, :, None].astype(v.dtype)
    return u * sv.reshape(B, S, D_GMLP)


def _pool_mixer(c, pool_w, pool_scale):
    B, S, _ = c.shape
    dg = D_POOL // N_POOL_GROUPS
    cf = c.astype(jnp.float32)
    cs = jnp.concatenate([jnp.zeros((B, 1, D_POOL), jnp.float32), jnp.cumsum(cf, axis=1)], axis=1)
    t = jnp.arange(S)
    outs = []
    for gi, w in enumerate(POOL_WINDOWS):
        lo = jnp.maximum(t + 1 - w, 0)
        sl = slice(gi * dg, (gi + 1) * dg)
        csg = cs[:, :, sl]
        count = (t + 1 - lo).astype(jnp.float32)[None, :, None]
        mean = (csg[:, 1:] - csg[:, lo]) / count
        diff = (mean - cf[:, :, sl]).astype(c.dtype)
        outs.append(jnp.einsum('bsc,cd->bsd', diff, pool_w[gi]))
    return jnp.concatenate(outs, axis=-1) * pool_scale


def _token_mixer(xn, w_in, sgu_norm_g, sgu_w, sgu_b, pool_w, pool_scale, w_out_a, w_out_b, w_o):
    z = xn @ w_in
    i1 = D_GMLP
    i2 = 2 * D_GMLP
    i3 = i2 + D_POOL
    i4 = i3 + D_MODEL
    u = jax.nn.gelu(z[..., :i1])
    v = jax.nn.gelu(z[..., i1:i2])
    c = z[..., i2:i3]
    ga = z[..., i3:i4]
    gb = z[..., i4:]
    a = _spatial_gating(u, v, sgu_norm_g, sgu_w, sgu_b)
    b = _pool_mixer(c, pool_w, pool_scale)
    y = jax.nn.sigmoid(ga) * (a @ w_out_a) + jax.nn.sigmoid(gb) * (b @ w_out_b)
    return y @ w_o


def _gain(k, shape):
    return 1.0 + 0.02 * jax.random.normal(k, shape, jnp.float32)


def _w(k, shape, fan_in):
    return jax.random.normal(k, shape, jnp.float32) * (fan_in ** -0.5)


def setup_inputs(seed: int = 0) -> dict:
    key = jax.random.key(seed)
    ks = jax.random.split(key, 32)
    L = DEPTH
    dgp = D_POOL // N_POOL_GROUPS
    return {
        "x": jax.random.normal(ks[0], (BATCH, SEQ, D_MODEL), jnp.float32),
        "p": jax.random.normal(ks[1], (DEPTH, BATCH, SEQ, D_PLE), jnp.float32),
        "ffn1_pre_g": _gain(ks[2], (L, D_MODEL)),
        "ffn1_w_gate": _w(ks[3], (L, D_MODEL, D_FF), D_MODEL),
        "ffn1_w_up": _w(ks[4], (L, D_MODEL, D_FF), D_MODEL),
        "ffn1_w_down": _w(ks[5], (L, D_FF, D_MODEL), D_FF),
        "ffn1_post_g": _gain(ks[6], (L, D_MODEL)),
        "mix_pre_g": _gain(ks[7], (L, D_MODEL)),
        "w_in": _w(ks[8], (L, D_MODEL, D_IN), D_MODEL),
        "sgu_norm_g": _gain(ks[9], (L, D_GMLP)),
        "sgu_w": _w(ks[10], (L, N_SGU_GROUPS, CHUNK, CHUNK), CHUNK),
        "sgu_b": _gain(ks[11], (L, N_SGU_GROUPS, CHUNK)),
        "pool_w": _w(ks[12], (L, N_POOL_GROUPS, dgp, dgp), dgp),
        "pool_scale": _gain(ks[13], (L, D_POOL)),
        "w_out_a": _w(ks[14], (L, D_GMLP, D_MODEL), D_GMLP),
        "w_out_b": _w(ks[15], (L, D_POOL, D_MODEL), D_POOL),
        "w_o": _w(ks[16], (L, D_MODEL, D_MODEL), D_MODEL),
        "mix_post_g": _gain(ks[17], (L, D_MODEL)),
        "ffn2_pre_g": _gain(ks[18], (L, D_MODEL)),
        "ffn2_w_gate": _w(ks[19], (L, D_MODEL, D_FF), D_MODEL),
        "ffn2_w_up": _w(ks[20], (L, D_MODEL, D_FF), D_MODEL),
        "ffn2_w_down": _w(ks[21], (L, D_FF, D_MODEL), D_FF),
        "ffn2_post_g": _gain(ks[22], (L, D_MODEL)),
        "ple_pre_g": _gain(ks[23], (L, D_MODEL)),
        "ple_w_gate": _w(ks[24], (L, D_MODEL, D_MODEL), D_MODEL),
        "ple_w_proj": _w(ks[25], (L, D_PLE, D_MODEL), D_PLE),
        "ple_post_g": _gain(ks[26], (L, D_MODEL)),
    }


def reference(x, p, ffn1_pre_g, ffn1_w_gate, ffn1_w_up, ffn1_w_down, ffn1_post_g,
              mix_pre_g, w_in, sgu_norm_g, sgu_w, sgu_b, pool_w, pool_scale,
              w_out_a, w_out_b, w_o, mix_post_g,
              ffn2_pre_g, ffn2_w_gate, ffn2_w_up, ffn2_w_down, ffn2_post_g,
              ple_pre_g, ple_w_gate, ple_w_proj, ple_post_g):
    h = x
    for i in range(DEPTH):
        f = _swiglu(_rmsnorm(h, ffn1_pre_g[i]), ffn1_w_gate[i], ffn1_w_up[i], ffn1_w_down[i])
        h = h + 0.5 * _rmsnorm(f, ffn1_post_g[i])
        m = _token_mixer(_rmsnorm(h, mix_pre_g[i]), w_in[i], sgu_norm_g[i], sgu_w[i], sgu_b[i],
                         pool_w[i], pool_scale[i], w_out_a[i], w_out_b[i], w_o[i])
        h = h + _rmsnorm(m, mix_post_g[i])
        f = _swiglu(_rmsnorm(h, ffn2_pre_g[i]), ffn2_w_gate[i], ffn2_w_up[i], ffn2_w_down[i])
        h = h + 0.5 * _rmsnorm(f, ffn2_post_g[i])
        gate = jax.nn.sigmoid(_rmsnorm(h, ple_pre_g[i]) @ ple_w_gate[i])
        e = p[i] @ ple_w_proj[i]
        h = h + _rmsnorm(gate * e, ple_post_g[i])
    return h
```

```cpp
#include <hip/hip_runtime.h>
#include <hip/hip_cooperative_groups.h>
#include <cstdio>
#include <cstdint>
#include <cstddef>
namespace cg = cooperative_groups;
#define MK_N_LAUNCHES 1
namespace pg8 {
#define PG8_LAS __attribute__((address_space(3)))
typedef unsigned short bf16_t;
typedef short bf16x8 __attribute__((ext_vector_type(8)));
typedef float f32x4 __attribute__((ext_vector_type(4)));
typedef unsigned u32x4 __attribute__((ext_vector_type(4)));
constexpr int BM = 256, BK = 64, HALF = 128, HTB = HALF * BK * 2  , STAGE_BYTES = 8 * HTB, NXCD = 8, WGM = 8;

__host__ __device__ __forceinline__ int lds_byte(int r, int c) { const int st = (r >> 4) * 2 + (c >> 5), rr = r & 15, cc = c & 31, ob = rr * 64 + cc * 2; return st * 1024 + (ob ^ (((ob >> 9) & 1) << 5)); }
__host__ __device__ __forceinline__ void stage_rc(int b, int& R, int& C) { const int st = b / 1024, sb = b % 1024, swz = sb ^ (((sb >> 9) & 1) << 5); R = (st >> 1) * 16 + swz / 64; C = (st & 1) * 32 + (swz % 64) / 2; }
__host__ __device__ __forceinline__ int perm32(int rho) { const int n = rho >> 4, i = rho & 15; return 8 * (i >> 2) + 4 * n + (i & 3); }

struct Unit { int pm, pn; };
struct Gemm { const bf16_t* A; const bf16_t* Bt; int M, N, K; };

struct StaticOrder {
    int nM, nN, nwg, G, c;
    __host__ __device__ void init(int M, int N, int G_, int c_) { nM = M / BM; nN = N / BM; nwg = nM * nN; G = G_; c = c_; }
    __host__ __device__ bool next(int i, Unit& u) const {
        const long L = (long)i * G + c; if (L >= nwg) return false;
        int wgid = (int)L; { const int q = nwg / NXCD, r = nwg % NXCD, xcd = wgid % NXCD, off = wgid / NXCD; wgid = (xcd < r ? xcd * (q + 1) : r * (q + 1) + (xcd - r) * q) + off; }
        const int nig = WGM * nN, gid = wgid / nig, fm = gid * WGM, gsz = (nM - fm) < WGM ? (nM - fm) : WGM;
        u.pm = fm + ((wgid % nig) % gsz); u.pn = (wgid % nig) / gsz; return true;
    }
    __device__ __forceinline__ void a_ready(const Unit&) const {}
    __device__ __forceinline__ void done(const Unit&) const {}
};
__device__ __forceinline__ unsigned cvt_pk_bf16(float lo, float hi) { unsigned r; asm volatile("v_cvt_pk_bf16_f32 %0, %1, %2" : "=v"(r) : "v"(lo), "v"(hi)); return r; }
typedef float f32x2 __attribute__((ext_vector_type(2)));
template <class Epi, class Sched, bool ALIGN_EPI = false, bool SP2 = false, int NT = 0  , bool ZIGZAG = false  , bool PEEL = false  >
__device__ __forceinline__ void gemm_phase(PG8_LAS unsigned char* lds, const Gemm g, const Sched& S, const Epi& E) {
    const int tid = threadIdx.x, wid = __builtin_amdgcn_readfirstlane(tid >> 6), lane = tid & 63, wr = wid >> 2, wc = wid & 3, fr = lane & 15, fq = lane >> 4;
    const int K = g.K, nt = K / BK;
    unsigned voffA[2], voffB[2];
#pragma unroll
    for (int i = 0; i < 2; ++i) { int R, C; stage_rc(tid * 16 + i * 8192, R, C); const int Rb = Epi::PERM ? ((R & ~31) + perm32(R & 31)) : R;
        voffA[i] = (unsigned)(R * K + C) * 2u; voffB[i] = (unsigned)(Rb * K + C) * 2u; }
    const size_t kstep = (size_t)(BK * 2);
    const size_t hstep = (size_t)HALF * K * 2;
    const size_t tstep = 2 * hstep;
    const unsigned ldsw = (unsigned)wid * 1024u;
    const int aoff = lds_byte(wr * 64 + fr, fq * 8), boff = lds_byte(wc * 32 + fr, fq * 8);
#define PG8_SA(b, h) (((b) * 2 + (h)) * HTB)
#define PG8_SB(b, h) ((4 + (b) * 2 + (h)) * HTB)
    constexpr int AUX_A = (NT == 1) ? 2 : 0, AUX_B = (NT == 2) ? 2 : 0;
#define PG8_STAGE_T(bufoff, gbase, voff, AUX) do { _Pragma("unroll") for (int _i = 0; _i < 2; ++_i) \
        __builtin_amdgcn_global_load_lds((const unsigned*)((const char*)(gbase) + (voff)[_i]), (PG8_LAS unsigned*)(lds + (bufoff) + ldsw + _i * 8192), 16, 0, AUX); } while (0)
#define PG8_LDA(dst, b, h) do { _Pragma("unroll") for (int m = 0; m < 4; ++m) _Pragma("unroll") for (int k = 0; k < 2; ++k) dst[m][k] = *(const PG8_LAS bf16x8*)(lds + PG8_SA(b, h) + aoff + m * 2048 + k * 1024); } while (0)
#define PG8_LDB(dst, b, h) do { _Pragma("unroll") for (int n = 0; n < 2; ++n) _Pragma("unroll") for (int k = 0; k < 2; ++k) dst[n][k] = *(const PG8_LAS bf16x8*)(lds + PG8_SB(b, h) + boff + n * 2048 + k * 1024); } while (0)
#define PG8_MMA(ai, bj, At, Bt) do { __builtin_amdgcn_s_setprio(1); _Pragma("unroll") for (int m = 0; m < 4; ++m) _Pragma("unroll") for (int n = 0; n < 2; ++n) _Pragma("unroll") for (int k = 0; k < 2; ++k) \
        acc[ai][bj][m][n] = __builtin_amdgcn_mfma_f32_16x16x32_bf16(Bt[n][k], At[m][k], acc[ai][bj][m][n], 0, 0, 0); __builtin_amdgcn_s_setprio(0); } while (0)
#define PG8_WAIT_V(n) asm volatile("s_waitcnt vmcnt(" #n ")" ::: "memory")
#define PG8_WAIT_L(n) asm volatile("s_waitcnt lgkmcnt(" #n ")" ::: "memory")
#define PG8_BAR __builtin_amdgcn_s_barrier()
#define PG8_SCHED __builtin_amdgcn_sched_barrier(0)
    Unit cur, nxt; int ui = 0;
    if (!S.next(0, cur)) return;
    f32x4 acc[2][2][4][2];
#pragma unroll
    for (int a = 0; a < 2; ++a)
#pragma unroll
        for (int b = 0; b < 2; ++b)
#pragma unroll
            for (int m = 0; m < 4; ++m)
#pragma unroll
                for (int n = 0; n < 2; ++n) acc[a][b][m][n] = (f32x4){0.f, 0.f, 0.f, 0.f};
    bf16x8 At[4][2], B0[2][2], B1[2][2];
    const char* cA = (const char*)g.A + (size_t)cur.pm * tstep; const char* cB = (const char*)g.Bt + (size_t)cur.pn * tstep;
    const ptrdiff_t kfwd = (ptrdiff_t)kstep, kspan = (ptrdiff_t)(nt - 1) * (ptrdiff_t)kstep; ptrdiff_t ck = kfwd;
    S.a_ready(cur);
    if constexpr (SP2) {
        PG8_STAGE_T(PG8_SB(0, 0), cB, voffB, AUX_B); PG8_STAGE_T(PG8_SB(0, 1), cB + hstep, voffB, AUX_B); PG8_STAGE_T(PG8_SA(0, 0), cA, voffA, AUX_A); PG8_STAGE_T(PG8_SA(0, 1), cA + hstep, voffA, AUX_A);
        if (wr == 1) PG8_BAR;
        PG8_WAIT_V(2); PG8_BAR;
        PG8_STAGE_T(PG8_SB(1, 0), cB + ck, voffB, AUX_B); PG8_STAGE_T(PG8_SA(1, 0), cA + ck, voffA, AUX_A); PG8_STAGE_T(PG8_SB(1, 1), cB + hstep + ck, voffB, AUX_B);
        PG8_WAIT_V(6); PG8_BAR;
    } else {
        PG8_STAGE_T(PG8_SB(0, 0), cB, voffB, AUX_B); PG8_STAGE_T(PG8_SA(0, 0), cA, voffA, AUX_A); PG8_STAGE_T(PG8_SB(0, 1), cB + hstep, voffB, AUX_B); PG8_STAGE_T(PG8_SA(0, 1), cA + hstep, voffA, AUX_A);
        if (wr == 1) PG8_BAR;
        PG8_WAIT_V(4); PG8_BAR;
        PG8_STAGE_T(PG8_SB(1, 0), cB + ck, voffB, AUX_B); PG8_STAGE_T(PG8_SA(1, 0), cA + ck, voffA, AUX_A); PG8_STAGE_T(PG8_SB(1, 1), cB + hstep + ck, voffB, AUX_B);
        PG8_WAIT_V(6); PG8_BAR;
    }
    for (;;) {
        const bool has_next = S.next(ui + 1, nxt);
        const bool nrev = ZIGZAG && (((ui + 1) & 1) != 0);
        const ptrdiff_t nk = has_next ? (nrev ? -kfwd : kfwd) : ck, noff = (has_next && nrev) ? kspan : 0;
        const char* nA = has_next ? (const char*)g.A + (size_t)nxt.pm * tstep + noff : cA; const char* nB = has_next ? (const char*)g.Bt + (size_t)nxt.pn * tstep + noff : cB;
        for (int t = 0; t < nt; t += 2) {
            const bool last = (t == nt - 2);
            const char* a1 = cA + (ptrdiff_t)(t + 1) * ck;
            const char* a2 = last ? nA : cA + (ptrdiff_t)(t + 2) * ck; const char* b2 = last ? nB : cB + (ptrdiff_t)(t + 2) * ck;
            const ptrdiff_t k3 = last ? nk : ck;
            const char* a3 = a2 + k3; const char* b3 = b2 + k3;
            if (last && has_next) S.a_ready(nxt);
            if constexpr (SP2) {
            int pei = 0; if constexpr (PEEL) { pei = __builtin_amdgcn_readfirstlane((t == 0 && ui > 0) ? 1 : 0); asm volatile("" : "+s"(pei)); }
            const bool pe = pei != 0;
            PG8_LDB(B0, 0, 0); PG8_LDB(B1, 0, 1); PG8_SCHED; PG8_LDA(At, 0, 0); if (!pe) { PG8_STAGE_T(PG8_SA(1, 1), a1 + hstep, voffA, AUX_A); }
            if (!pe) { PG8_WAIT_V(8); } PG8_WAIT_L(0); PG8_BAR; PG8_MMA(0, 0, At, B0); PG8_MMA(0, 1, At, B1); PG8_BAR; PG8_SCHED;
            PG8_LDA(At, 0, 1); PG8_STAGE_T(PG8_SB(0, 0), b2, voffB, AUX_B); PG8_STAGE_T(PG8_SB(0, 1), b2 + hstep, voffB, AUX_B); PG8_STAGE_T(PG8_SA(0, 0), a2, voffA, AUX_A);
            if (!pe) { PG8_WAIT_V(8); } PG8_WAIT_L(0); PG8_BAR; PG8_MMA(1, 0, At, B0); PG8_MMA(1, 1, At, B1); PG8_BAR; PG8_SCHED;
            PG8_LDB(B0, 1, 0); PG8_LDB(B1, 1, 1); PG8_SCHED; PG8_LDA(At, 1, 0); PG8_STAGE_T(PG8_SA(0, 1), a2 + hstep, voffA, AUX_A);
            if (!pe) { PG8_WAIT_V(8); } PG8_WAIT_L(0); PG8_BAR; PG8_MMA(0, 0, At, B0); PG8_MMA(0, 1, At, B1); PG8_BAR; PG8_SCHED;
            PG8_LDA(At, 1, 1); PG8_STAGE_T(PG8_SB(1, 0), b3, voffB, AUX_B); PG8_STAGE_T(PG8_SB(1, 1), b3 + hstep, voffB, AUX_B); PG8_STAGE_T(PG8_SA(1, 0), a3, voffA, AUX_A);
            PG8_WAIT_V(8); PG8_WAIT_L(0); PG8_BAR; PG8_MMA(1, 0, At, B0); PG8_MMA(1, 1, At, B1); PG8_BAR; PG8_SCHED;
            } else {
            PG8_LDB(B0, 0, 0); PG8_SCHED; PG8_LDA(At, 0, 0); PG8_STAGE_T(PG8_SA(1, 1), a1 + hstep, voffA, AUX_A);
            PG8_WAIT_L(8); PG8_BAR; PG8_WAIT_L(0); PG8_MMA(0, 0, At, B0); PG8_BAR; PG8_SCHED;
            PG8_LDB(B1, 0, 1); PG8_STAGE_T(PG8_SB(0, 0), b2, voffB, AUX_B);
            PG8_BAR; PG8_WAIT_L(0); PG8_MMA(0, 1, At, B1); PG8_BAR;
            PG8_LDA(At, 0, 1); PG8_STAGE_T(PG8_SA(0, 0), a2, voffA, AUX_A);
            PG8_BAR; PG8_WAIT_L(0); PG8_MMA(1, 0, At, B0); PG8_BAR; PG8_SCHED;
            PG8_STAGE_T(PG8_SB(0, 1), b2 + hstep, voffB, AUX_B);
            PG8_WAIT_V(6); PG8_BAR; PG8_MMA(1, 1, At, B1); PG8_BAR;
            PG8_LDB(B0, 1, 0); PG8_SCHED; PG8_LDA(At, 1, 0); PG8_STAGE_T(PG8_SA(0, 1), a2 + hstep, voffA, AUX_A);
            PG8_WAIT_L(8); PG8_BAR; PG8_WAIT_L(0); PG8_MMA(0, 0, At, B0); PG8_BAR; PG8_SCHED;
            PG8_LDB(B1, 1, 1); PG8_STAGE_T(PG8_SB(1, 0), b3, voffB, AUX_B);
            PG8_BAR; PG8_WAIT_L(0); PG8_MMA(0, 1, At, B1); PG8_BAR;
            PG8_LDA(At, 1, 1); PG8_STAGE_T(PG8_SA(1, 0), a3, voffA, AUX_A);
            PG8_BAR; PG8_WAIT_L(0); PG8_MMA(1, 0, At, B0); PG8_BAR; PG8_SCHED;
            PG8_STAGE_T(PG8_SB(1, 1), b3 + hstep, voffB, AUX_B);
            PG8_WAIT_V(6); PG8_BAR; PG8_MMA(1, 1, At, B1); PG8_BAR;
            }
        }
        if constexpr (ALIGN_EPI) { if (wr == 0) PG8_BAR; }
        if constexpr (PEEL) { static_assert(ALIGN_EPI && SP2, "PEEL is written for the aligned two-super-phase loop");
            PG8_STAGE_T(PG8_SA(1, 1), nA + nk + hstep, voffA, AUX_A); }
        if constexpr (!Epi::AFTER_DRAIN) { E(acc, cur, wr, wc, fr, fq); S.done(cur); }
        if (!has_next) break;
        if constexpr (PEEL) { PG8_WAIT_V(8); }
#pragma unroll
        for (int a = 0; a < 2; ++a)
#pragma unroll
            for (int b = 0; b < 2; ++b)
#pragma unroll
                for (int m = 0; m < 4; ++m)
#pragma unroll
                    for (int n = 0; n < 2; ++n) acc[a][b][m][n] = (f32x4){0.f, 0.f, 0.f, 0.f};
        cur = nxt; cA = nA; cB = nB; ck = nk; ++ui;
        if constexpr (ALIGN_EPI) { if (wr == 1) PG8_BAR; }
    }
    PG8_WAIT_V(0);
    if constexpr (!ALIGN_EPI) { if (wr == 0) PG8_BAR; }
    PG8_BAR;
    if constexpr (Epi::AFTER_DRAIN) { E.fused(acc, cur, wr, wc, fr, fq, lds, wid, lane); S.done(cur); }
#undef PG8_SA
#undef PG8_SB
#undef PG8_STAGE_T
#undef PG8_LDA
#undef PG8_LDB
#undef PG8_MMA
#undef PG8_WAIT_V
#undef PG8_WAIT_L
#undef PG8_BAR
#undef PG8_SCHED
}
}

#define LAS __attribute__((address_space(3)))
typedef unsigned short bf16;
typedef unsigned v4u __attribute__((ext_vector_type(4)));
typedef unsigned v2u __attribute__((ext_vector_type(2)));
typedef float f32x4 __attribute__((ext_vector_type(4)));
typedef short bf16x8 __attribute__((ext_vector_type(8)));

#ifndef MK_N_LAUNCHES
#define MK_N_LAUNCHES 1
#endif
constexpr int N_PHASES = 15;
#ifndef ALIGN_GU
#define ALIGN_GU true
#endif
#ifndef PEELK
#define PEELK false
#endif
#ifndef ZZ
#define ZZ false
#endif
#ifndef NT_WIDE
#define NT_WIDE 0
#endif
#ifndef NT_NARROW
#define NT_NARROW 0
#endif
constexpr int NWAVES = 8;
constexpr int M = 32768, D = 1024, FF = 2816, DIN = 5120, DPLE = 256;
constexpr float EPS = 1e-6f;
constexpr size_t MiB = 1u << 20;
constexpr size_t WS_WGU1 = 0 * MiB;
constexpr size_t WS_WD1 = 11 * MiB;
constexpr size_t WS_WIN = 17 * MiB;
constexpr size_t WS_WOA = 27 * MiB, WS_WOB = 29 * MiB, WS_WO = 31 * MiB;
constexpr size_t WS_WGU2 = 33 * MiB, WS_WD2 = 44 * MiB;
constexpr size_t WS_WPG = 50 * MiB;
constexpr size_t WS_WPP = 52 * MiB;
constexpr size_t WS_PWT = 53 * MiB;
constexpr size_t WS_SGW = 54 * MiB;
constexpr size_t WS_PART = 55 * MiB;
constexpr size_t WS_CTL = 57 * MiB, CTL_BYTES = 16384;
constexpr size_t WS_RS = 57 * MiB + 65536;
constexpr size_t WS_VST = 75 * MiB;
constexpr size_t WS_PB = 58 * MiB;
constexpr size_t WS_SLAB = 80 * MiB, SLAB = 64 * MiB;
constexpr size_t WS_END = WS_SLAB + 6 * SLAB;
constexpr int LDS_BYTES = 147456, MISC_OFF = 147392, RS_TAB_OFF = 131072, RS_KEY_OFF = 131072 + 4096;

__device__ __forceinline__ float bf_lo(unsigned w) { return __uint_as_float(w << 16); }
__device__ __forceinline__ float bf_hi(unsigned w) { return __uint_as_float(w & 0xffff0000u); }
typedef __bf16 bf16x2_t __attribute__((ext_vector_type(2)));
typedef float f32x2_t __attribute__((ext_vector_type(2)));
__device__ __forceinline__ unsigned pk2(float lo, float hi) { bf16x2_t r = __builtin_convertvector((f32x2_t){lo, hi}, bf16x2_t); return __builtin_bit_cast(unsigned, r); }
#ifndef WT_STORES
#define WT_STORES 0
#endif
__device__ __forceinline__ void st16_wt(void* p, v4u v) {
#if WT_STORES
    asm volatile("s_nop 1\n\tglobal_store_dwordx4 %0, %1, off sc1" :: "v"(p), "v"(v) : "memory");
#else
    *(v4u*)p = v;
#endif
}
__device__ __forceinline__ void st8_wt(void* p, v2u v) {
#if WT_STORES
    asm volatile("s_nop 1\n\tglobal_store_dwordx2 %0, %1, off sc1" :: "v"(p), "v"(v) : "memory");
#else
    *(v2u*)p = v;
#endif
}
__device__ __forceinline__ void st4_wt(void* p, float v) {
#if WT_STORES
    asm volatile("s_nop 1\n\tglobal_store_dword %0, %1, off sc1" :: "v"(p), "v"(v) : "memory");
#else
    *(float*)p = v;
#endif
}
__device__ __forceinline__ float sigmoid_fast(float x) { return __builtin_amdgcn_rcpf(1.0f + __builtin_amdgcn_exp2f(-1.44269504089f * x)); }
__device__ __forceinline__ float gelu_tanh(float x) { return x * sigmoid_fast(1.5957691216f * (x + 0.044715f * x * x * x)); }
__device__ __forceinline__ float wave_sum(float v) {
#pragma unroll
    for (int o = 1; o < 64; o <<= 1) v += __shfl_xor(v, o);
    return v;
}


__device__ __forceinline__ void rs_table_fill(LAS unsigned char* lds, const pg8::StaticOrder& S, const float* rs) {
    int k0 = -1, k1 = -1, k2 = -1, k3 = -1;
    for (int i = 0;; ++i) { pg8::Unit u; if (!S.next(i, u)) break; const int pm = u.pm;
        if (pm != k0 && pm != k1 && pm != k2 && pm != k3) { if (k0 < 0) k0 = pm; else if (k1 < 0) k1 = pm; else if (k2 < 0) k2 = pm; else if (k3 < 0) k3 = pm; } }
    const int tid = threadIdx.x;
    LAS float* tab = (LAS float*)(lds + RS_TAB_OFF); LAS int* keys = (LAS int*)(lds + RS_KEY_OFF);
    if (tid < 256) {
        if (k0 >= 0) tab[tid] = rs[k0 * 256 + tid];
        if (k1 >= 0) tab[256 + tid] = rs[k1 * 256 + tid];
        if (k2 >= 0) tab[512 + tid] = rs[k2 * 256 + tid];
        if (k3 >= 0) tab[768 + tid] = rs[k3 * 256 + tid];
    }
    if (tid == 0) { keys[0] = k0; keys[1] = k1; keys[2] = k2; keys[3] = k3; }
    __syncthreads();
}
__device__ __forceinline__ void rs_rows(const LAS unsigned char* lds, const float* rs, int pm, int wr, int fr, float (&rv)[2][4]) {
    const LAS int* keys = (const LAS int*)(lds + RS_KEY_OFF); const LAS float* tab = (const LAS float*)(lds + RS_TAB_OFF);
    const int k0 = keys[0], k1 = keys[1], k2 = keys[2], k3 = keys[3];
    const int idx = (pm == k0) ? 0 : (pm == k1) ? 1 : (pm == k2) ? 2 : (pm == k3) ? 3 : -1;
    const int rl = wr * 64 + fr;
    if (idx >= 0) {
#pragma unroll
        for (int ai = 0; ai < 2; ++ai)
#pragma unroll
            for (int m = 0; m < 4; ++m) rv[ai][m] = tab[idx * 256 + rl + ai * 128 + m * 16];
    } else {
#pragma unroll
        for (int ai = 0; ai < 2; ++ai)
#pragma unroll
            for (int m = 0; m < 4; ++m) rv[ai][m] = rs[pm * 256 + rl + ai * 128 + m * 16];
    }
}
struct EpiGU {
    static constexpr bool PERM = true, AFTER_DRAIN = false;
    bf16* O; const float* rs; const LAS unsigned char* lds;
    __device__ __forceinline__ void operator()(const pg8::f32x4 (&acc)[2][2][4][2], const pg8::Unit& u, int wr, int wc, int fr, int fq) const {
        const int row0 = u.pm * 256 + wr * 64 + fr, col0 = u.pn * 128 + wc * 32 + 8 * fq;
        float rvs[2][4]; rs_rows(lds, rs, u.pm, wr, fr, rvs);
#pragma unroll
        for (int ai = 0; ai < 2; ++ai)
#pragma unroll
            for (int m = 0; m < 4; ++m) {
                const float rv = rvs[ai][m];
                bf16* p = O + (size_t)(row0 + ai * 128 + m * 16) * FF + col0;
                const pg8::f32x4 g0 = acc[ai][0][m][0] * rv, g1 = acc[ai][0][m][1] * rv, u0 = acc[ai][1][m][0] * rv, u1 = acc[ai][1][m][1] * rv;
                float r[8];
#pragma unroll
                for (int j = 0; j < 4; ++j) { r[j] = g0[j] * sigmoid_fast(g0[j]) * u0[j]; r[4 + j] = g1[j] * sigmoid_fast(g1[j]) * u1[j]; }
                v4u w; w.x = pk2(r[0], r[1]); w.y = pk2(r[2], r[3]); w.z = pk2(r[4], r[5]); w.w = pk2(r[6], r[7]);
                __builtin_nontemporal_store(w, (v4u*)p);
            }
    }
};
template <int ACT  , bool GATE, bool ADD, bool PART, bool RSCALE = false> struct EpiN {
    static constexpr bool PERM = true, AFTER_DRAIN = false;
    bf16* O; const bf16* G; const bf16* A2; float* part; const float* rs; const LAS unsigned char* lds;
    __device__ __forceinline__ void operator()(const pg8::f32x4 (&acc)[2][2][4][2], const pg8::Unit& u, int wr, int wc, int fr, int fq) const {
        const int row0 = u.pm * 256 + wr * 64 + fr, col0 = u.pn * 256 + wc * 32 + 8 * fq;
        float rvs[2][4];
        if (RSCALE) rs_rows(lds, rs, u.pm, wr, fr, rvs);
#pragma unroll
        for (int ai = 0; ai < 2; ++ai) {
            v4u gq[4][2], aq[4][2];
            if (GATE) {
#pragma unroll
                for (int m = 0; m < 4; ++m)
#pragma unroll
                    for (int bj = 0; bj < 2; ++bj) gq[m][bj] = *(const v4u*)(G + (size_t)(row0 + ai * 128 + m * 16) * D + col0 + bj * 128);
            }
            if (ADD) {
#pragma unroll
                for (int m = 0; m < 4; ++m)
#pragma unroll
                    for (int bj = 0; bj < 2; ++bj) aq[m][bj] = *(const v4u*)(A2 + (size_t)(row0 + ai * 128 + m * 16) * D + col0 + bj * 128);
            }
#pragma unroll
            for (int m = 0; m < 4; ++m) {
                const int row = row0 + ai * 128 + m * 16;
                const size_t off = (size_t)row * D + col0;
                float s = 0.f;
#pragma unroll
                for (int bj = 0; bj < 2; ++bj) {
                    float r[8];
#pragma unroll
                    for (int j = 0; j < 4; ++j) { r[j] = acc[ai][bj][m][0][j]; r[4 + j] = acc[ai][bj][m][1][j]; }
                    if (RSCALE) { const float rv = rvs[ai][m];
#pragma unroll
                        for (int j = 0; j < 8; ++j) r[j] *= rv; }
                    if (ACT == 1) {
#pragma unroll
                        for (int j = 0; j < 8; ++j) r[j] = sigmoid_fast(r[j]);
                    }
                    if (GATE) { const v4u g = gq[m][bj];
                        r[0] *= bf_lo(g.x); r[1] *= bf_hi(g.x); r[2] *= bf_lo(g.y); r[3] *= bf_hi(g.y); r[4] *= bf_lo(g.z); r[5] *= bf_hi(g.z); r[6] *= bf_lo(g.w); r[7] *= bf_hi(g.w); }
                    if (ADD) { const v4u g = aq[m][bj];
                        r[0] += bf_lo(g.x); r[1] += bf_hi(g.x); r[2] += bf_lo(g.y); r[3] += bf_hi(g.y); r[4] += bf_lo(g.z); r[5] += bf_hi(g.z); r[6] += bf_lo(g.w); r[7] += bf_hi(g.w); }
                    if (PART) {
#pragma unroll
                        for (int j = 0; j < 8; ++j) s += r[j] * r[j];
                    }
                    v4u w; w.x = pk2(r[0], r[1]); w.y = pk2(r[2], r[3]); w.z = pk2(r[4], r[5]); w.w = pk2(r[6], r[7]);
                    st16_wt(O + off + bj * 128, w);
                }
                if (PART) { s += __shfl_xor(s, 16); s += __shfl_xor(s, 32); st4_wt(part + (size_t)row * 16 + u.pn * 4 + wc, s); }
            }
            if (GATE || ADD) asm volatile("" ::: "memory");
        }
    }
};
struct EpiIn {
    static constexpr bool PERM = true, AFTER_DRAIN = false;
    bf16* base; const float* rs; const LAS unsigned char* lds; float* vst;
    __device__ __forceinline__ void operator()(const pg8::f32x4 (&acc)[2][2][4][2], const pg8::Unit& u, int wr, int wc, int fr, int fq) const {
        float rvs[2][4]; rs_rows(lds, rs, u.pm, wr, fr, rvs);
        const int t = u.pn >> 2;
        bf16* O = base + (size_t)t * (SLAB / 2);
        const int row0 = u.pm * 256 + wr * 64 + fr, col0 = (u.pn & 3) * 256 + wc * 32 + 8 * fq;
#pragma unroll
        for (int ai = 0; ai < 2; ++ai)
#pragma unroll
            for (int m = 0; m < 4; ++m) {
                const size_t off = (size_t)(row0 + ai * 128 + m * 16) * D + col0;
                const float rv = rvs[ai][m];
                float s1 = 0.f, s2 = 0.f;
#pragma unroll
                for (int bj = 0; bj < 2; ++bj) {
                    float r[8];
#pragma unroll
                    for (int j = 0; j < 4; ++j) { r[j] = acc[ai][bj][m][0][j] * rv; r[4 + j] = acc[ai][bj][m][1][j] * rv; }
                    if (t < 2) {
#pragma unroll
                        for (int j = 0; j < 8; ++j) r[j] = gelu_tanh(r[j]);
                        if (t == 1) {
#pragma unroll
                            for (int j = 0; j < 8; ++j) { s1 += r[j]; s2 += r[j] * r[j]; }
                        }
                    } else if (t > 2) {
#pragma unroll
                        for (int j = 0; j < 8; ++j) r[j] = sigmoid_fast(r[j]);
                    }
                    v4u w; w.x = pk2(r[0], r[1]); w.y = pk2(r[2], r[3]); w.z = pk2(r[4], r[5]); w.w = pk2(r[6], r[7]);
                    __builtin_nontemporal_store(w, (v4u*)(O + off + bj * 128));
                }
                if (t == 1) {
                    s1 += __shfl_xor(s1, 16); s1 += __shfl_xor(s1, 32); s2 += __shfl_xor(s2, 16); s2 += __shfl_xor(s2, 32);
                    f32x2_t pr; pr.x = s1; pr.y = s2;
                    *(f32x2_t*)(vst + ((size_t)(row0 + ai * 128 + m * 16) * 16 + (u.pn & 3) * 4 + wc) * 2) = pr;
                }
            }
    }
};

template <bool HASG> __device__ __forceinline__ void transpose_item(const float* W, int K, int N, bf16* WT, int k0, int n0, int orow0, const float* gk, LAS float* scr, int lane) {
    float w[32], gv[32];
    const float* src = W + (size_t)(k0 + (lane >> 5)) * N + n0 + (lane & 31);
#pragma unroll
    for (int i = 0; i < 32; ++i) w[i] = __builtin_nontemporal_load(src + (size_t)(2 * i) * N);
    if (HASG) {
#pragma unroll
        for (int i = 0; i < 32; ++i) gv[i] = gk[k0 + 2 * i + (lane >> 5)];
    }
#pragma unroll
    for (int i = 0; i < 32; ++i) { const int kk = 2 * i + (lane >> 5); scr[kk * 33 + (lane & 31)] = HASG ? w[i] * gv[i] : w[i]; }
    asm volatile("s_waitcnt lgkmcnt(0)" ::: "memory");
    const int c = lane & 7;
#pragma unroll
    for (int j = 0; j < 4; ++j) { const int n = (lane >> 3) + 8 * j; const LAS float* s = scr + (8 * c) * 33 + n;
        v4u o; o.x = pk2(s[0 * 33], s[1 * 33]); o.y = pk2(s[2 * 33], s[3 * 33]); o.z = pk2(s[4 * 33], s[5 * 33]); o.w = pk2(s[6 * 33], s[7 * 33]);
        *(v4u*)(WT + (size_t)(orow0 + n) * K + k0 + 8 * c) = o; }
    asm volatile("s_waitcnt lgkmcnt(0)" ::: "memory");
}
template <bool HASG> __device__ __forceinline__ bool transpose_mat(int& r, const float* W, int K, int N, bf16* WT, int mode, const float* gk, LAS float* scr, int lane) {
    const int nblk = N / 32, cnt = (K / 64) * nblk;
    if (r >= cnt) { r -= cnt; return false; }
    const int kb = r / nblk, nb = r % nblk, n0 = 32 * nb;
    const int orow0 = mode < 0 ? n0 : 256 * (n0 >> 7) + (n0 & 127) + 128 * mode;
    transpose_item<HASG>(W, K, N, WT, 64 * kb, n0, orow0, gk, scr, lane);
    return true;
}
__device__ __forceinline__ void xrow_load(f32x4 (&v)[4][4], const float* x, int rb, int lane) {
#pragma unroll
    for (int i = 0; i < 4; ++i)
#pragma unroll
        for (int j = 0; j < 4; ++j) v[i][j] = __builtin_nontemporal_load((const f32x4*)(x + (size_t)(rb + i) * D) + lane + 64 * j);
}
__device__ __forceinline__ void xrow_store(const f32x4 (&v)[4][4], bf16* hb, float* rs_out, int rb, int lane) {
#pragma unroll
    for (int i = 0; i < 4; ++i) {
        float s = 0.f;
#pragma unroll
        for (int j = 0; j < 4; ++j) s += (v[i][j].x * v[i][j].x + v[i][j].y * v[i][j].y) + (v[i][j].z * v[i][j].z + v[i][j].w * v[i][j].w);
        const float tot = wave_sum(s);
        if (lane == 0) rs_out[rb + i] = 1.0f / sqrtf(tot * (1.f / D) + EPS);
        v2u* o8 = (v2u*)(hb + (size_t)(rb + i) * D) + lane;
#pragma unroll
        for (int j = 0; j < 4; ++j) { v2u o; o.x = pk2(v[i][j].x, v[i][j].y); o.y = pk2(v[i][j].z, v[i][j].w); o8[64 * j] = o; }
    }
}
__device__ __forceinline__ void x_rows_to_bf16(const float* x, bf16* hb, float* rs_out, int gw, int NGW, int lane) {
    constexpr int R = 4; const int step = NGW * R;
    f32x4 a[4][4], b[4][4];
    int rb = gw * R;
    if (rb < M) xrow_load(a, x, rb, lane);
#pragma unroll 1
    for (; rb < M; rb += 2 * step) {
        const int nb = rb + step, nb2 = nb + step;
        if (nb < M) xrow_load(b, x, nb, lane);
        xrow_store(a, hb, rs_out, rb, lane);
        if (nb2 < M) xrow_load(a, x, nb2, lane);
        if (nb < M) xrow_store(b, hb, rs_out, nb, lane);
    }
}
template <bool SRC_F32, int R> struct EwSet { float p[R]; v2u fw[R][4]; f32x4 h32[SRC_F32 ? R : 1][4]; v2u hb[SRC_F32 ? 1 : R][4]; };
template <bool SRC_F32, int R> __device__ __forceinline__ void ew_load(EwSet<SRC_F32, R>& S, int rb, const float* hsrc32, const bf16* hsrcb, const bf16* f, const float* part, int lane) {
#pragma unroll
    for (int i = 0; i < R; ++i) S.p[i] = (lane < 16) ? part[(size_t)(rb + i) * 16 + lane] : 0.f;
#pragma unroll
    for (int i = 0; i < R; ++i)
#pragma unroll
        for (int j = 0; j < 4; ++j) {
            S.fw[i][j] = ((const v2u*)(f + (size_t)(rb + i) * D) + lane)[64 * j];
            if constexpr (SRC_F32) S.h32[i][j] = __builtin_nontemporal_load((const f32x4*)(hsrc32 + (size_t)(rb + i) * D) + lane + 64 * j);
            else S.hb[i][j] = ((const v2u*)(hsrcb + (size_t)(rb + i) * D) + lane)[64 * j];
        }
}
template <bool SRC_F32, bool FINAL, int R> __device__ __forceinline__ void ew_compute(const EwSet<SRC_F32, R>& S, int rb, const f32x4 (&g)[4], bf16* hb_out, float* out32, float scale, float* rs_out, int lane) {
#pragma unroll
    for (int i = 0; i < R; ++i) {
        float q = S.p[i];
        q += __shfl_xor(q, 1); q += __shfl_xor(q, 2); q += __shfl_xor(q, 4); q += __shfl_xor(q, 8);
        const float ss = __shfl(q, 0);
        const float rs = scale / sqrtf(ss * (1.f / D) + EPS);
        float s2 = 0.f;
#pragma unroll
        for (int j = 0; j < 4; ++j) {
            f32x4 h;
            if constexpr (SRC_F32) h = S.h32[i][j];
            else { const v2u hw = S.hb[i][j]; h.x = bf_lo(hw.x); h.y = bf_hi(hw.x); h.z = bf_lo(hw.y); h.w = bf_hi(hw.y); }
            const v2u fw = S.fw[i][j];
            f32x4 v; v.x = h.x + bf_lo(fw.x) * rs * g[j].x; v.y = h.y + bf_hi(fw.x) * rs * g[j].y; v.z = h.z + bf_lo(fw.y) * rs * g[j].z; v.w = h.w + bf_hi(fw.y) * rs * g[j].w;
            if (FINAL) __builtin_nontemporal_store(v, (f32x4*)(out32 + (size_t)(rb + i) * D) + lane + 64 * j);
            else { v2u o; o.x = pk2(v.x, v.y); o.y = pk2(v.z, v.w); ((v2u*)(hb_out + (size_t)(rb + i) * D) + lane)[64 * j] = o; s2 += (v.x * v.x + v.y * v.y) + (v.z * v.z + v.w * v.w); }
        }
        if (!FINAL) { const float tot = wave_sum(s2); if (lane == 0) rs_out[rb + i] = 1.0f / sqrtf(tot * (1.f / D) + EPS); }
    }
}
template <bool SRC_F32, bool FINAL> __device__ __forceinline__ void ew_phase(const float* hsrc32, const bf16* hsrcb, bf16* hb_out, float* out32, const bf16* f, const float* part, const float* gpost, float scale, float* rs_out, int gw, int NGW, int lane) {
    constexpr int R = SRC_F32 ? 2 : 4;
    f32x4 g[4];
#pragma unroll
    for (int j = 0; j < 4; ++j) g[j] = ((const f32x4*)gpost + lane)[64 * j];
    const int step = NGW * R;
    EwSet<SRC_F32, R> A, B;
    int rb = gw * R;
    if (rb < M) ew_load<SRC_F32, R>(A, rb, hsrc32, hsrcb, f, part, lane);
#pragma unroll 1
    for (; rb < M; rb += 2 * step) {
        const int nb = rb + step, nb2 = nb + step;
        if (nb < M) ew_load<SRC_F32, R>(B, nb, hsrc32, hsrcb, f, part, lane);
        ew_compute<SRC_F32, FINAL, R>(A, rb, g, hb_out, out32, scale, rs_out, lane);
        if (nb2 < M) ew_load<SRC_F32, R>(A, nb2, hsrc32, hsrcb, f, part, lane);
        if (nb < M) ew_compute<SRC_F32, FINAL, R>(B, nb, g, hb_out, out32, scale, rs_out, lane);
    }
}

constexpr int MX_WS_PITCH = 272, MX_T_PITCH = 528, MX_T_OFF = 75520, MX_STAT_OFF = MX_T_OFF + 128 * MX_T_PITCH  ;
__device__ __forceinline__ void unpack8(const v4u w, float (&x)[8]) { x[0] = bf_lo(w.x); x[1] = bf_hi(w.x); x[2] = bf_lo(w.y); x[3] = bf_hi(w.y); x[4] = bf_lo(w.z); x[5] = bf_hi(w.z); x[6] = bf_lo(w.w); x[7] = bf_hi(w.w); }
__device__ __forceinline__ void mixer_phase(LAS unsigned char* lds, bf16* U  , const bf16* V, const bf16* C, bf16* Bout,
                                            const bf16* wsb, const float* sgu_b, const float* sgu_g, const bf16* pwT, const float* pool_scale, const float* vst, int G, int bid) {
    const int tid = threadIdx.x, wid = __builtin_amdgcn_readfirstlane(tid >> 6), lane = tid & 63, fr = lane & 15, fq = lane >> 4;
    LAS float* stat = (LAS float*)(lds + MX_STAT_OFF);
    for (int q = bid; q < M / 128; q += G) {
        const int r0 = q * 128;
#pragma unroll
        for (int ib = 0; ib < 16; ib += 4) {
            const int sr = wid * 16 + ib + (lane >> 4);
            const f32x2_t pr = *(const f32x2_t*)(vst + ((size_t)(r0 + sr) * 16 + (lane & 15)) * 2);
            float a = pr.x, b = pr.y;
            a += __shfl_xor(a, 1); a += __shfl_xor(a, 2); a += __shfl_xor(a, 4); a += __shfl_xor(a, 8);
            b += __shfl_xor(b, 1); b += __shfl_xor(b, 2); b += __shfl_xor(b, 4); b += __shfl_xor(b, 8);
            const float mean = a * (1.f / D); float var = b * (1.f / D) - mean * mean; var = var > 0.f ? var : 0.f;
            if ((lane & 15) == 0) { stat[2 * sr] = mean; stat[2 * sr + 1] = 1.0f / sqrtf(var + EPS); }
        }
        __syncthreads();
#pragma unroll 1
        for (int g = 0; g < 4; ++g) {
            {
                v4u wv[4], vv[8];
#pragma unroll
                for (int i = 0; i < 4; ++i) { const int id = tid + 512 * i; wv[i] = *(const v4u*)(wsb + (size_t)g * 16384 + (id >> 4) * 128 + (id & 15) * 8); }
                const int c8 = tid & 31;
#pragma unroll
                for (int i = 0; i < 8; ++i) vv[i] = *(const v4u*)(V + (size_t)(r0 + (tid >> 5) + 16 * i) * D + g * 256 + c8 * 8);
                const f32x4 g0 = *(const f32x4*)(sgu_g + g * 256 + c8 * 8), g1 = *(const f32x4*)(sgu_g + g * 256 + c8 * 8 + 4);
#pragma unroll
                for (int i = 0; i < 4; ++i) { const int id = tid + 512 * i; *(LAS v4u*)(lds + (id >> 4) * MX_WS_PITCH + (id & 15) * 16) = wv[i]; }
#pragma unroll
                for (int i = 0; i < 8; ++i) { const int sr = (tid >> 5) + 16 * i;
                    float x[8]; unpack8(vv[i], x);
                    const float mean = stat[2 * sr], rstd = stat[2 * sr + 1];
                    v4u w; w.x = pk2((x[0] - mean) * rstd * g0.x, (x[1] - mean) * rstd * g0.y); w.y = pk2((x[2] - mean) * rstd * g0.z, (x[3] - mean) * rstd * g0.w);
                    w.z = pk2((x[4] - mean) * rstd * g1.x, (x[5] - mean) * rstd * g1.y); w.w = pk2((x[6] - mean) * rstd * g1.z, (x[7] - mean) * rstd * g1.w);
                    *(LAS v4u*)(lds + MX_T_OFF + sr * MX_T_PITCH + c8 * 16) = w; }
            }
            __syncthreads();
            v4u uu[8];
#pragma unroll
            for (int m = 0; m < 8; ++m) uu[m] = *(const v4u*)(U + (size_t)(r0 + 16 * m + fr) * D + g * 256 + 32 * wid + 8 * fq);
            f32x4 acc[8][2];
#pragma unroll
            for (int m = 0; m < 8; ++m) { acc[m][0] = (f32x4){0.f, 0.f, 0.f, 0.f}; acc[m][1] = (f32x4){0.f, 0.f, 0.f, 0.f}; }
            const int dch = 32 * wid + 8 * (fr >> 2) + (fr & 3);
#pragma unroll 1
            for (int k = 0; k < 4; ++k) {
                bf16x8 vf[2];
#pragma unroll
                for (int n = 0; n < 2; ++n)
#pragma unroll
                    for (int i = 0; i < 8; ++i) vf[n][i] = *(const LAS short*)(lds + MX_T_OFF + (32 * k + 8 * fq + i) * MX_T_PITCH + (dch + 4 * n) * 2);
#pragma unroll
                for (int m = 0; m < 8; ++m) {
                    if (16 * m + 15 >= 32 * k) {
                        const bf16x8 wf = *(const LAS bf16x8*)(lds + (16 * m + fr) * MX_WS_PITCH + (32 * k + 8 * fq) * 2);
                        acc[m][0] = __builtin_amdgcn_mfma_f32_16x16x32_bf16(vf[0], wf, acc[m][0], 0, 0, 0);
                        acc[m][1] = __builtin_amdgcn_mfma_f32_16x16x32_bf16(vf[1], wf, acc[m][1], 0, 0, 0);
                    }
                }
            }
#pragma unroll
            for (int m = 0; m < 8; ++m) {
                const int t = 16 * m + fr; const float bias = sgu_b[g * 128 + t];
                bf16* up = U + (size_t)(r0 + t) * D + g * 256 + 32 * wid + 8 * fq;
                float x[8]; unpack8(uu[m], x);
                v4u w; w.x = pk2(x[0] * (acc[m][0][0] + bias), x[1] * (acc[m][0][1] + bias)); w.y = pk2(x[2] * (acc[m][0][2] + bias), x[3] * (acc[m][0][3] + bias));
                w.z = pk2(x[4] * (acc[m][1][0] + bias), x[5] * (acc[m][1][1] + bias)); w.w = pk2(x[6] * (acc[m][1][2] + bias), x[7] * (acc[m][1][3] + bias));
                st16_wt(up, w);
            }
            __syncthreads();
        }
#pragma unroll 1
        for (int gi = 0; gi < 4; ++gi) {
            const int w = 2 << gi;
            bf16x8 pf[8][2];
            { const bf16* pw = pwT + (size_t)gi * 65536 + (size_t)(32 * wid + 8 * (fr >> 2) + (fr & 3)) * 256 + 8 * fq;
#pragma unroll
              for (int k = 0; k < 8; ++k) { pf[k][0] = *(const bf16x8*)(pw + 32 * k); pf[k][1] = *(const bf16x8*)(pw + 4 * 256 + 32 * k); } }
            {
                const bool has_hist = (q & 31) != 0;
                v4u cv[9];
#pragma unroll
                for (int i = 0; i < 9; ++i) { const int id = tid + 512 * i, row = id >> 5, c8 = id & 31;
                    cv[i] = (v4u){0u, 0u, 0u, 0u};
                    if (id < 143 * 32 && (row >= 15 || has_hist)) cv[i] = *(const v4u*)(C + ((ptrdiff_t)r0 + row - 15) * D + gi * 256 + c8 * 8); }
#pragma unroll
                for (int i = 0; i < 9; ++i) { const int id = tid + 512 * i, row = id >> 5, c8 = id & 31;
                    if (id < 143 * 32) *(LAS v4u*)(lds + row * MX_T_PITCH + c8 * 16) = cv[i]; }
            }
            __syncthreads();
            {
                const int c8 = tid & 31, t0 = (tid >> 5) * 8, pos0 = (q & 31) * 128 + t0;
                const LAS unsigned char* rp = lds + (t0 + 15) * MX_T_PITCH + c8 * 16;
                float S[8];
#pragma unroll
                for (int e = 0; e < 8; ++e) S[e] = 0.f;
                for (int j = 1; j < w; ++j) { float x[8]; unpack8(*(const LAS v4u*)(rp - j * MX_T_PITCH), x);
#pragma unroll
                    for (int e = 0; e < 8; ++e) S[e] += x[e]; }
#pragma unroll
                for (int i = 0; i < 8; ++i) {
                    const int pos = pos0 + i;
                    float x[8], y[8]; unpack8(*(const LAS v4u*)(rp + i * MX_T_PITCH), x); unpack8(*(const LAS v4u*)(rp + (i - w + 1) * MX_T_PITCH), y);
                    const float inv = 1.0f / (float)(pos + 1 < w ? pos + 1 : w);
                    float d[8];
#pragma unroll
                    for (int e = 0; e < 8; ++e) { S[e] += x[e]; d[e] = S[e] * inv - x[e]; S[e] -= y[e]; }
                    v4u o; o.x = pk2(d[0], d[1]); o.y = pk2(d[2], d[3]); o.z = pk2(d[4], d[5]); o.w = pk2(d[6], d[7]);
                    *(LAS v4u*)(lds + MX_T_OFF + (t0 + i) * MX_T_PITCH + c8 * 16) = o;
                }
            }
            __syncthreads();
            f32x4 acc[8][2];
#pragma unroll
            for (int m = 0; m < 8; ++m) { acc[m][0] = (f32x4){0.f, 0.f, 0.f, 0.f}; acc[m][1] = (f32x4){0.f, 0.f, 0.f, 0.f}; }
#pragma unroll
            for (int k = 0; k < 8; ++k) {
#pragma unroll
                for (int m = 0; m < 8; ++m) {
                    const bf16x8 df = *(const LAS bf16x8*)(lds + MX_T_OFF + (16 * m + fr) * MX_T_PITCH + (32 * k + 8 * fq) * 2);
                    acc[m][0] = __builtin_amdgcn_mfma_f32_16x16x32_bf16(pf[k][0], df, acc[m][0], 0, 0, 0);
                    acc[m][1] = __builtin_amdgcn_mfma_f32_16x16x32_bf16(pf[k][1], df, acc[m][1], 0, 0, 0);
                }
            }
            {
                const int ch = gi * 256 + 32 * wid + 8 * fq;
                const f32x4 s0 = *(const f32x4*)(pool_scale + ch), s1 = *(const f32x4*)(pool_scale + ch + 4);
#pragma unroll
                for (int m = 0; m < 8; ++m) {
                    const int t = 16 * m + fr;
                    v4u o; o.x = pk2(acc[m][0][0] * s0.x, acc[m][0][1] * s0.y); o.y = pk2(acc[m][0][2] * s0.z, acc[m][0][3] * s0.w);
                    o.z = pk2(acc[m][1][0] * s1.x, acc[m][1][1] * s1.y); o.w = pk2(acc[m][1][2] * s1.z, acc[m][1][3] * s1.w);
                    st16_wt(Bout + (size_t)(r0 + t) * D + ch, o);
                }
            }
            __syncthreads();
        }
    }
}

#define XB_TMO      128
#define XB_XCNT(j)  (256  + 64 * (j))
#define XB_XSUB(j)  (1280 + 64 * (j))
#define XB_XGEN(j)  (2304 + 64 * (j))
#define XB_TOP      3328
#define XB_TOPGEN   3392
#define XCD_BAR_WORDS 3456
#define XB_SPIN_CAP (1u << 18)

__device__ __forceinline__ unsigned xb_ld(unsigned* p)              { return __hip_atomic_load(p, __ATOMIC_RELAXED, __HIP_MEMORY_SCOPE_AGENT); }
__device__ __forceinline__ unsigned xb_add(unsigned* p, unsigned v) { return __hip_atomic_fetch_add(p, v, __ATOMIC_RELAXED, __HIP_MEMORY_SCOPE_AGENT); }
__device__ __forceinline__ unsigned xb_xcc_id() { return (unsigned)__builtin_amdgcn_s_getreg((3 << 11) | 20) & 0xFu; }
#define XB_SPIN(cond, bar) do { unsigned _sp = 0; while (cond) { __builtin_amdgcn_s_sleep(1); \
    if ((++_sp & 255u) == 0u) { if (xb_ld(&(bar)[XB_TMO])) break; if (_sp > XB_SPIN_CAP) { atomicAdd(&(bar)[XB_TMO], 1u); break; } } } } while (0)

struct XcdBarrier {
    unsigned* bar; unsigned x;
    volatile LAS unsigned* st;
};

__device__ __forceinline__ XcdBarrier xcd_barrier_post(unsigned* bar, volatile LAS unsigned* st) {
    XcdBarrier b; b.bar = bar; b.x = xb_xcc_id(); b.st = st;
    if (threadIdx.x == 0) (void)xb_add(&bar[XB_XCNT(b.x)], 1u);
    return b;
}
__device__ __forceinline__ void xcd_barrier_complete(unsigned* bar, unsigned x, unsigned& nloc, unsigned& nx) {
    const unsigned G = gridDim.x * gridDim.y * gridDim.z;
    unsigned sum, cnt, mine, sp = 0u;
    for (;;) {
        sum = 0u; cnt = 0u; mine = 0u;
#pragma unroll
        for (unsigned j = 0; j < 16; ++j) { const unsigned c = xb_ld(&bar[XB_XCNT(j)]); sum += c; cnt += (c > 0u) ? 1u : 0u; mine = (j == x) ? c : mine; }
        if (sum == G) break;
        __builtin_amdgcn_s_sleep(1);
        if ((++sp & 255u) == 0u) { if (xb_ld(&bar[XB_TMO])) break; if (sp > XB_SPIN_CAP) { atomicAdd(&bar[XB_TMO], 1u); break; } }
    }
    nloc = mine > 0u ? mine : 1u; nx = cnt > 0u ? cnt : 1u;
}

__device__ __forceinline__ void xcd_barrier(const XcdBarrier& b) {
    asm volatile("s_waitcnt vmcnt(0)" ::: "memory");
    __syncthreads();
    if (threadIdx.x == 0) {
        unsigned* bar = b.bar;
        __builtin_amdgcn_s_waitcnt(0);
        unsigned nloc = b.st[0], nx = b.st[1];
        if (nloc == 0u) { xcd_barrier_complete(bar, b.x, nloc, nx); b.st[0] = nloc; b.st[1] = nx; }
        const unsigned old = xb_add(&bar[XB_XSUB(b.x)], 1u);
        const unsigned gen = old / nloc;
        if (old + 1u == (gen + 1u) * nloc) {
            __builtin_amdgcn_fence(__ATOMIC_RELEASE, "agent");
            asm volatile("s_waitcnt vmcnt(0)" ::: "memory");
            const unsigned og = xb_add(&bar[XB_TOP], 1u);
            const unsigned tg = og / nx;
            if (og + 1u == (tg + 1u) * nx) xb_add(&bar[XB_TOPGEN], 1u);
            else XB_SPIN(xb_ld(&bar[XB_TOPGEN]) == tg, bar);
            __builtin_amdgcn_fence(__ATOMIC_ACQUIRE, "agent");
            xb_add(&bar[XB_XGEN(b.x)], 1u);
            asm volatile("s_waitcnt vmcnt(0)" ::: "memory");
        } else {
            XB_SPIN(xb_ld(&bar[XB_XGEN(b.x)]) == gen, bar);
            __builtin_amdgcn_fence(__ATOMIC_ACQUIRE, "agent");
            asm volatile("s_waitcnt vmcnt(0)" ::: "memory");
        }
    }
    __syncthreads();
}


__device__ __forceinline__ int opq(int v) { asm volatile("" : "+s"(v)); return v; }
struct Args { const float* in[27]; float* out; unsigned char* ws; int ph_lo, ph_hi; };
enum { I_X = 0, I_P, I_F1PRE, I_F1G, I_F1U, I_F1D, I_F1POST, I_MIXPRE, I_WIN, I_SGUG, I_SGUW, I_SGUB, I_POOLW, I_POOLS, I_WOA, I_WOB, I_WO, I_MIXPOST,
       I_F2PRE, I_F2G, I_F2U, I_F2D, I_F2POST, I_PLEPRE, I_PLEG, I_PLEP, I_PLEPOST };

__global__ void __launch_bounds__(NWAVES * 64, 2) mk_fwd(Args a) {
    extern __shared__ __attribute__((aligned(16))) unsigned char lds_raw[];
    LAS unsigned char* lds = (LAS unsigned char*)lds_raw;
    const int tid = threadIdx.x, lane = tid & 63, wave = __builtin_amdgcn_readfirstlane(tid >> 6);
    const int G = gridDim.x, bid = blockIdx.x;
    const int gw = bid * NWAVES + wave, NGW = G * NWAVES;
    unsigned char* ws = a.ws;
    bf16* WGU1 = (bf16*)(ws + WS_WGU1); bf16* WD1 = (bf16*)(ws + WS_WD1); bf16* WIN = (bf16*)(ws + WS_WIN);
    bf16* WOA = (bf16*)(ws + WS_WOA); bf16* WOB = (bf16*)(ws + WS_WOB); bf16* WO = (bf16*)(ws + WS_WO);
    bf16* WGU2 = (bf16*)(ws + WS_WGU2); bf16* WD2 = (bf16*)(ws + WS_WD2); bf16* WPG = (bf16*)(ws + WS_WPG); bf16* WPP = (bf16*)(ws + WS_WPP);
    bf16* PWT = (bf16*)(ws + WS_PWT); bf16* SGW = (bf16*)(ws + WS_SGW); float* PART = (float*)(ws + WS_PART); bf16* PB = (bf16*)(ws + WS_PB);
    bf16* S0 = (bf16*)(ws + WS_SLAB); bf16* S1 = (bf16*)(ws + WS_SLAB + SLAB); bf16* S2 = (bf16*)(ws + WS_SLAB + 2 * SLAB);
    bf16* S3 = (bf16*)(ws + WS_SLAB + 3 * SLAB); bf16* S4 = (bf16*)(ws + WS_SLAB + 4 * SLAB); bf16* S5 = (bf16*)(ws + WS_SLAB + 5 * SLAB);
    bf16* XN = S0; bf16* ACT = S1; bf16* FB = S4;
    float* RS = (float*)(ws + WS_RS); bf16* HB = S0;
    bf16* BB = (bf16*)a.out;
    const int lo = a.ph_lo, hi = a.ph_hi;
#ifndef PH_MASK
#define PH_MASK 0x7fff
#endif
#define IN(k) (((PH_MASK >> (k)) & 1) && lo <= (k) && (k) < hi)
#ifndef DUP_MASK
#define DUP_MASK 0
#endif
#define NDUP(k) (1 + ((DUP_MASK >> (k)) & 1))
    if (tid < 2) ((LAS unsigned*)(lds + MISC_OFF))[tid] = 0u;
    __syncthreads();
    XcdBarrier xbar; xbar.bar = (unsigned*)(ws + WS_CTL); xbar.x = 0; xbar.st = nullptr;
    if (hi - lo > 1) xbar = xcd_barrier_post((unsigned*)(ws + WS_CTL), (volatile LAS unsigned*)(lds + MISC_OFF));
#define SEAM(k) do { if (IN(k) && IN((k) + 1)) { xcd_barrier(xbar); } } while (0)
    if (lo < 0) cg::this_grid().sync();

    if (IN(0)) {
        LAS float* scr = (LAS float*)(lds + wave * 16384);
        constexpr int NITEMS = 13312;
        for (int it = gw; it < NITEMS; it += NGW) {
            int r = it;
            if (transpose_mat<true>(r, a.in[I_F1G], D, FF, WGU1, 0, a.in[I_F1PRE], scr, lane)) continue;
            if (transpose_mat<true>(r, a.in[I_F1U], D, FF, WGU1, 1, a.in[I_F1PRE], scr, lane)) continue;
            if (transpose_mat<false>(r, a.in[I_F1D], FF, D, WD1, -1, nullptr, scr, lane)) continue;
            if (transpose_mat<true>(r, a.in[I_WIN], D, DIN, WIN, -1, a.in[I_MIXPRE], scr, lane)) continue;
            if (transpose_mat<false>(r, a.in[I_WOA], D, D, WOA, -1, nullptr, scr, lane)) continue;
            if (transpose_mat<false>(r, a.in[I_WOB], D, D, WOB, -1, nullptr, scr, lane)) continue;
            if (transpose_mat<false>(r, a.in[I_WO], D, D, WO, -1, nullptr, scr, lane)) continue;
            if (transpose_mat<true>(r, a.in[I_F2G], D, FF, WGU2, 0, a.in[I_F2PRE], scr, lane)) continue;
            if (transpose_mat<true>(r, a.in[I_F2U], D, FF, WGU2, 1, a.in[I_F2PRE], scr, lane)) continue;
            if (transpose_mat<false>(r, a.in[I_F2D], FF, D, WD2, -1, nullptr, scr, lane)) continue;
            if (transpose_mat<true>(r, a.in[I_PLEG], D, D, WPG, -1, a.in[I_PLEPRE], scr, lane)) continue;
            if (transpose_mat<false>(r, a.in[I_PLEP], DPLE, D, WPP, -1, nullptr, scr, lane)) continue;
            if (transpose_mat<false>(r, a.in[I_POOLW], 256, 256, PWT, -1, nullptr, scr, lane)) continue;
            if (transpose_mat<false>(r, a.in[I_POOLW] + 65536, 256, 256, PWT + 65536, -1, nullptr, scr, lane)) continue;
            if (transpose_mat<false>(r, a.in[I_POOLW] + 2 * 65536, 256, 256, PWT + 2 * 65536, -1, nullptr, scr, lane)) continue;
            transpose_mat<false>(r, a.in[I_POOLW] + 3 * 65536, 256, 256, PWT + 3 * 65536, -1, nullptr, scr, lane);
        }
        for (int i = bid * 512 + tid; i < 4 * 128 * 128; i += G * 512) { const int t = (i >> 7) & 127, s = i & 127; const float v = (s <= t) ? a.in[I_SGUW][i] : 0.f; SGW[i] = (bf16)(pk2(v, 0.f) & 0xffffu); }
        for (int i0 = bid * 512 + tid; i0 < M * DPLE / 8; i0 += 4 * G * 512) {
            f32x4 x0[4], x1[4];
#pragma unroll
            for (int j = 0; j < 4; ++j) { const int i = i0 + j * G * 512; if (i < M * DPLE / 8) { x0[j] = __builtin_nontemporal_load((const f32x4*)a.in[I_P] + 2 * i); x1[j] = __builtin_nontemporal_load((const f32x4*)a.in[I_P] + 2 * i + 1); } }
#pragma unroll
            for (int j = 0; j < 4; ++j) { const int i = i0 + j * G * 512; if (i < M * DPLE / 8) { v4u o; o.x = pk2(x0[j].x, x0[j].y); o.y = pk2(x0[j].z, x0[j].w); o.z = pk2(x1[j].x, x1[j].y); o.w = pk2(x1[j].z, x1[j].w); ((v4u*)PB)[i] = o; } }
        }
        x_rows_to_bf16(a.in[I_X], HB, RS, gw, NGW, lane);
    }
    SEAM(0);
    if (IN(1)) { pg8::Gemm g{XN, WGU1, M, 2 * FF, D}; pg8::StaticOrder S; S.init(M, 2 * FF, G, bid); EpiGU E{ACT, RS, lds}; rs_table_fill(lds, S, RS);
        pg8::gemm_phase<EpiGU, pg8::StaticOrder, ALIGN_GU, true, NT_WIDE, ZZ, PEELK>(lds, g, S, E); }
    SEAM(1);
    if (IN(2)) { pg8::Gemm g{ACT, WD1, M, D, FF}; pg8::StaticOrder S; S.init(M, D, G, bid); EpiN<0, false, false, true> E{FB, nullptr, nullptr, PART};
        pg8::gemm_phase<EpiN<0, false, false, true>, pg8::StaticOrder, true, true, NT_NARROW, ZZ, PEELK>(lds, g, S, E); }
    SEAM(2);
    if (IN(3)) ew_phase<true, false>(a.in[I_X], nullptr, HB, nullptr, FB, PART, a.in[I_F1POST], 0.5f, RS, gw, NGW, lane);
    SEAM(3);
    if (IN(4)) { pg8::Gemm g{XN, WIN, M, DIN, D}; pg8::StaticOrder S; S.init(M, DIN, G, bid); EpiIn E{S1, RS, lds, (float*)(ws + WS_VST)}; rs_table_fill(lds, S, RS);
        pg8::gemm_phase<EpiIn, pg8::StaticOrder, true, true, NT_WIDE, ZZ, PEELK>(lds, g, S, E); }
    SEAM(4);
    if (IN(5)) mixer_phase(lds, S1, S2, S3, BB, SGW, a.in[I_SGUB], a.in[I_SGUG], PWT, a.in[I_POOLS], (const float*)(ws + WS_VST), G, bid);
    SEAM(5);
    if (IN(6)) {
        { pg8::Gemm g{S1, WOA, M, D, D}; pg8::StaticOrder S; S.init(M, D, G, bid); EpiN<0, true, false, false> E{S2, S4, nullptr, nullptr};
          pg8::gemm_phase<EpiN<0, true, false, false>, pg8::StaticOrder, true, true, NT_NARROW, ZZ, PEELK>(lds, g, S, E); }
        { pg8::Gemm g{BB, WOB, M, D, D}; pg8::StaticOrder S; S.init(M, D, G, bid); EpiN<0, true, true, false> E{S2, S5, S2, nullptr};
          pg8::gemm_phase<EpiN<0, true, true, false>, pg8::StaticOrder, true, true, NT_NARROW, ZZ, PEELK>(lds, g, S, E); }
    }
    SEAM(6);
    if (IN(7)) { pg8::Gemm g{S2, WO, M, D, D}; pg8::StaticOrder S; S.init(M, D, G, bid); EpiN<0, false, false, true> E{S3, nullptr, nullptr, PART};
        pg8::gemm_phase<EpiN<0, false, false, true>, pg8::StaticOrder, true, true, NT_NARROW, ZZ, PEELK>(lds, g, S, E); }
    SEAM(7);
    if (IN(8)) ew_phase<false, false>(nullptr, HB, HB, nullptr, S3, PART, a.in[I_MIXPOST], 1.0f, RS, gw, NGW, lane);
    SEAM(8);
    if (IN(9)) { pg8::Gemm g{XN, WGU2, M, 2 * FF, D}; pg8::StaticOrder S; S.init(M, 2 * FF, G, bid); EpiGU E{ACT, RS, lds}; rs_table_fill(lds, S, RS);
        pg8::gemm_phase<EpiGU, pg8::StaticOrder, ALIGN_GU, true, NT_WIDE, ZZ, PEELK>(lds, g, S, E); }
    SEAM(9);
    if (IN(10)) { pg8::Gemm g{ACT, WD2, M, D, FF}; pg8::StaticOrder S; S.init(M, D, G, bid); EpiN<0, false, false, true> E{FB, nullptr, nullptr, PART};
        pg8::gemm_phase<EpiN<0, false, false, true>, pg8::StaticOrder, true, true, NT_NARROW, ZZ, PEELK>(lds, g, S, E); }
    SEAM(10);
    if (IN(11)) ew_phase<false, false>(nullptr, HB, HB, nullptr, FB, PART, a.in[I_F2POST], 0.5f, RS, gw, NGW, lane);
    SEAM(11);
    if (IN(12)) {
        { pg8::Gemm g{XN, WPG, M, D, D}; pg8::StaticOrder S; S.init(M, D, G, bid); EpiN<1, false, false, false, true> E{S1, nullptr, nullptr, nullptr, RS, lds}; rs_table_fill(lds, S, RS);
          pg8::gemm_phase<EpiN<1, false, false, false, true>, pg8::StaticOrder, true, true, NT_NARROW, ZZ, PEELK>(lds, g, S, E); }
    }
    if (IN(13)) {
        { int kp = DPLE; asm volatile("" : "+s"(kp));
          pg8::Gemm g{PB, WPP, M, D, kp}; pg8::StaticOrder S; S.init(M, D, G, bid); EpiN<0, true, false, true> E{FB, S1, nullptr, PART};
          pg8::gemm_phase<EpiN<0, true, false, true>, pg8::StaticOrder, true, true, NT_NARROW, ZZ, PEELK>(lds, g, S, E); }
    }
    SEAM(13);
    if (IN(14)) ew_phase<false, true>(nullptr, HB, nullptr, a.out, FB, PART, a.in[I_PLEPOST], 1.0f, nullptr, gw, NGW, lane);
#undef IN
#undef SEAM
}

extern "C" void kernel_launch(void* const* d_in, const int* in_sizes, int n_in, void* d_out, int out_size, void* d_ws, size_t ws_size, hipStream_t stream) {
    static int grid = 0;
    if (grid == 0) {
        if (n_in != 27 || out_size != M * D || ws_size < WS_END) { fprintf(stderr, "kernel_launch: unexpected shapes (n_in %d out %d ws %zu)\n", n_in, out_size, ws_size); grid = -1; return; }
        int dev = 0, cus = 0, per_cu = 0;
        hipGetDevice(&dev); hipDeviceGetAttribute(&cus, hipDeviceAttributeMultiprocessorCount, dev);
        if (hipFuncSetAttribute((const void*)mk_fwd, hipFuncAttributeMaxDynamicSharedMemorySize, LDS_BYTES) != hipSuccess) { fprintf(stderr, "kernel_launch: hipFuncSetAttribute failed\n"); grid = -1; return; }
        if (hipOccupancyMaxActiveBlocksPerMultiprocessor(&per_cu, (const void*)mk_fwd, NWAVES * 64, LDS_BYTES) != hipSuccess || per_cu < 1) { fprintf(stderr, "kernel_launch: occupancy query says %d\n", per_cu); per_cu = 1; }
        (void)hipGetLastError();
        if (per_cu > 1) per_cu = 1;
        grid = cus * per_cu;
        if (grid <= 0) grid = 256;
    }
    if (grid < 0) return;
#ifdef DBG_MEMSET
    (void)hipMemsetAsync(d_ws, 0, WS_END, stream); (void)hipMemsetAsync(d_out, 0, (size_t)M * D * 4, stream);
#endif
    (void)hipMemsetAsync((char*)d_ws + WS_CTL, 0, CTL_BYTES, stream);
    Args a{};
    for (int i = 0; i < 27; ++i) a.in[i] = (const float*)d_in[i];
    a.out = (float*)d_out; a.ws = (unsigned char*)d_ws;
#if MK_N_LAUNCHES == 1
    a.ph_lo = 0; a.ph_hi = N_PHASES;
    void* args[] = {&a};
    hipError_t e = hipLaunchCooperativeKernel((void*)mk_fwd, dim3(grid), dim3(NWAVES * 64), args, LDS_BYTES, stream);
    if (e != hipSuccess) fprintf(stderr, "kernel_launch: cooperative launch failed: %s (grid %d)\n", hipGetErrorString(e), grid);
#else
    for (int p = 0; p < N_PHASES; ++p) for (int d = 0; d < NDUP(p); ++d) { a.ph_lo = p; a.ph_hi = p + 1; hipLaunchKernelGGL(mk_fwd, dim3(grid), dim3(NWAVES * 64), LDS_BYTES, stream, a); }
#endif
}
```

```cpp
#include <hip/hip_runtime.h>
#include <hip/hip_cooperative_groups.h>
#include <cstdio>
#include <cstdint>
#include <cstddef>
namespace cg = cooperative_groups;
#define MK_N_LAUNCHES 1
namespace pg8 {
#define PG8_LAS __attribute__((address_space(3)))
typedef unsigned short bf16_t;
typedef short bf16x8 __attribute__((ext_vector_type(8)));
typedef float f32x4 __attribute__((ext_vector_type(4)));
typedef unsigned u32x4 __attribute__((ext_vector_type(4)));
constexpr int BM = 256, BK = 64, HALF = 128, HTB = HALF * BK * 2  , STAGE_BYTES = 8 * HTB, NXCD = 8, WGM = 8;

__host__ __device__ __forceinline__ int lds_byte(int r, int c) { const int st = (r >> 4) * 2 + (c >> 5), rr = r & 15, cc = c & 31, ob = rr * 64 + cc * 2; return st * 1024 + (ob ^ (((ob >> 9) & 1) << 5)); }
__host__ __device__ __forceinline__ void stage_rc(int b, int& R, int& C) { const int st = b / 1024, sb = b % 1024, swz = sb ^ (((sb >> 9) & 1) << 5); R = (st >> 1) * 16 + swz / 64; C = (st & 1) * 32 + (swz % 64) / 2; }
__host__ __device__ __forceinline__ int perm32(int rho) { const int n = rho >> 4, i = rho & 15; return 8 * (i >> 2) + 4 * n + (i & 3); }

struct Unit { int pm, pn; };
struct Gemm { const bf16_t* A; const bf16_t* Bt; int M, N, K; };

struct StaticOrder {
    int nM, nN, nwg, G, c;
    __host__ __device__ void init(int M, int N, int G_, int c_) { nM = M / BM; nN = N / BM; nwg = nM * nN; G = G_; c = c_; }
    __host__ __device__ bool next(int i, Unit& u) const {
        const long L = (long)i * G + c; if (L >= nwg) return false;
        int wgid = (int)L; { const int q = nwg / NXCD, r = nwg % NXCD, xcd = wgid % NXCD, off = wgid / NXCD; wgid = (xcd < r ? xcd * (q + 1) : r * (q + 1) + (xcd - r) * q) + off; }
        const int nig = WGM * nN, gid = wgid / nig, fm = gid * WGM, gsz = (nM - fm) < WGM ? (nM - fm) : WGM;
        u.pm = fm + ((wgid % nig) % gsz); u.pn = (wgid % nig) / gsz; return true;
    }
    __device__ __forceinline__ void a_ready(const Unit&) const {}
    __device__ __forceinline__ void done(const Unit&) const {}
};
__device__ __forceinline__ unsigned cvt_pk_bf16(float lo, float hi) { unsigned r; asm volatile("v_cvt_pk_bf16_f32 %0, %1, %2" : "=v"(r) : "v"(lo), "v"(hi)); return r; }
typedef float f32x2 __attribute__((ext_vector_type(2)));
template <class Epi, class Sched, bool ALIGN_EPI = false, bool SP2 = false, int NT = 0  , bool ZIGZAG = false  , bool PEEL = false  >
__device__ __forceinline__ void gemm_phase(PG8_LAS unsigned char* lds, const Gemm g, const Sched& S, const Epi& E) {
    const int tid = threadIdx.x, wid = __builtin_amdgcn_readfirstlane(tid >> 6), lane = tid & 63, wr = wid >> 2, wc = wid & 3, fr = lane & 15, fq = lane >> 4;
    const int K = g.K, nt = K / BK;
    unsigned voffA[2], voffB[2];
#pragma unroll
    for (int i = 0; i < 2; ++i) { int R, C; stage_rc(tid * 16 + i * 8192, R, C); const int Rb = Epi::PERM ? ((R & ~31) + perm32(R & 31)) : R;
        voffA[i] = (unsigned)(R * K + C) * 2u; voffB[i] = (unsigned)(Rb * K + C) * 2u; }
    const size_t kstep = (size_t)(BK * 2);
    const size_t hstep = (size_t)HALF * K * 2;
    const size_t tstep = 2 * hstep;
    const unsigned ldsw = (unsigned)wid * 1024u;
    const int aoff = lds_byte(wr * 64 + fr, fq * 8), boff = lds_byte(wc * 32 + fr, fq * 8);
#define PG8_SA(b, h) (((b) * 2 + (h)) * HTB)
#define PG8_SB(b, h) ((4 + (b) * 2 + (h)) * HTB)
    constexpr int AUX_A = (NT == 1) ? 2 : 0, AUX_B = (NT == 2) ? 2 : 0;
#define PG8_STAGE_T(bufoff, gbase, voff, AUX) do { _Pragma("unroll") for (int _i = 0; _i < 2; ++_i) \
        __builtin_amdgcn_global_load_lds((const unsigned*)((const char*)(gbase) + (voff)[_i]), (PG8_LAS unsigned*)(lds + (bufoff) + ldsw + _i * 8192), 16, 0, AUX); } while (0)
#define PG8_LDA(dst, b, h) do { _Pragma("unroll") for (int m = 0; m < 4; ++m) _Pragma("unroll") for (int k = 0; k < 2; ++k) dst[m][k] = *(const PG8_LAS bf16x8*)(lds + PG8_SA(b, h) + aoff + m * 2048 + k * 1024); } while (0)
#define PG8_LDB(dst, b, h) do { _Pragma("unroll") for (int n = 0; n < 2; ++n) _Pragma("unroll") for (int k = 0; k < 2; ++k) dst[n][k] = *(const PG8_LAS bf16x8*)(lds + PG8_SB(b, h) + boff + n * 2048 + k * 1024); } while (0)
#define PG8_MMA(ai, bj, At, Bt) do { __builtin_amdgcn_s_setprio(1); _Pragma("unroll") for (int m = 0; m < 4; ++m) _Pragma("unroll") for (int n = 0; n < 2; ++n) _Pragma("unroll") for (int k = 0; k < 2; ++k) \
        acc[ai][bj][m][n] = __builtin_amdgcn_mfma_f32_16x16x32_bf16(Bt[n][k], At[m][k], acc[ai][bj][m][n], 0, 0, 0); __builtin_amdgcn_s_setprio(0); } while (0)
#define PG8_WAIT_V(n) asm volatile("s_waitcnt vmcnt(" #n ")" ::: "memory")
#define PG8_WAIT_L(n) asm volatile("s_waitcnt lgkmcnt(" #n ")" ::: "memory")
#define PG8_BAR __builtin_amdgcn_s_barrier()
#define PG8_SCHED __builtin_amdgcn_sched_barrier(0)
    Unit cur, nxt; int ui = 0;
    if (!S.next(0, cur)) return;
    f32x4 acc[2][2][4][2];
#pragma unroll
    for (int a = 0; a < 2; ++a)
#pragma unroll
        for (int b = 0; b < 2; ++b)
#pragma unroll
            for (int m = 0; m < 4; ++m)
#pragma unroll
                for (int n = 0; n < 2; ++n) acc[a][b][m][n] = (f32x4){0.f, 0.f, 0.f, 0.f};
    bf16x8 At[4][2], B0[2][2], B1[2][2];
    const char* cA = (const char*)g.A + (size_t)cur.pm * tstep; const char* cB = (const char*)g.Bt + (size_t)cur.pn * tstep;
    const ptrdiff_t kfwd = (ptrdiff_t)kstep, kspan = (ptrdiff_t)(nt - 1) * (ptrdiff_t)kstep; ptrdiff_t ck = kfwd;
    S.a_ready(cur);
    if constexpr (SP2) {
        PG8_STAGE_T(PG8_SB(0, 0), cB, voffB, AUX_B); PG8_STAGE_T(PG8_SB(0, 1), cB + hstep, voffB, AUX_B); PG8_STAGE_T(PG8_SA(0, 0), cA, voffA, AUX_A); PG8_STAGE_T(PG8_SA(0, 1), cA + hstep, voffA, AUX_A);
        if (wr == 1) PG8_BAR;
        PG8_WAIT_V(2); PG8_BAR;
        PG8_STAGE_T(PG8_SB(1, 0), cB + ck, voffB, AUX_B); PG8_STAGE_T(PG8_SA(1, 0), cA + ck, voffA, AUX_A); PG8_STAGE_T(PG8_SB(1, 1), cB + hstep + ck, voffB, AUX_B);
        PG8_WAIT_V(6); PG8_BAR;
    } else {
        PG8_STAGE_T(PG8_SB(0, 0), cB, voffB, AUX_B); PG8_STAGE_T(PG8_SA(0, 0), cA, voffA, AUX_A); PG8_STAGE_T(PG8_SB(0, 1), cB + hstep, voffB, AUX_B); PG8_STAGE_T(PG8_SA(0, 1), cA + hstep, voffA, AUX_A);
        if (wr == 1) PG8_BAR;
        PG8_WAIT_V(4); PG8_BAR;
        PG8_STAGE_T(PG8_SB(1, 0), cB + ck, voffB, AUX_B); PG8_STAGE_T(PG8_SA(1, 0), cA + ck, voffA, AUX_A); PG8_STAGE_T(PG8_SB(1, 1), cB + hstep + ck, voffB, AUX_B);
        PG8_WAIT_V(6); PG8_BAR;
    }
    for (;;) {
        const bool has_next = S.next(ui + 1, nxt);
        const bool nrev = ZIGZAG && (((ui + 1) & 1) != 0);
        const ptrdiff_t nk = has_next ? (nrev ? -kfwd : kfwd) : ck, noff = (has_next && nrev) ? kspan : 0;
        const char* nA = has_next ? (const char*)g.A + (size_t)nxt.pm * tstep + noff : cA; const char* nB = has_next ? (const char*)g.Bt + (size_t)nxt.pn * tstep + noff : cB;
        for (int t = 0; t < nt; t += 2) {
            const bool last = (t == nt - 2);
            const char* a1 = cA + (ptrdiff_t)(t + 1) * ck;
            const char* a2 = last ? nA : cA + (ptrdiff_t)(t + 2) * ck; const char* b2 = last ? nB : cB + (ptrdiff_t)(t + 2) * ck;
            const ptrdiff_t k3 = last ? nk : ck;
            const char* a3 = a2 + k3; const char* b3 = b2 + k3;
            if (last && has_next) S.a_ready(nxt);
            if constexpr (SP2) {
            int pei = 0; if constexpr (PEEL) { pei = __builtin_amdgcn_readfirstlane((t == 0 && ui > 0) ? 1 : 0); asm volatile("" : "+s"(pei)); }
            const bool pe = pei != 0;
            PG8_LDB(B0, 0, 0); PG8_LDB(B1, 0, 1); PG8_SCHED; PG8_LDA(At, 0, 0); if (!pe) { PG8_STAGE_T(PG8_SA(1, 1), a1 + hstep, voffA, AUX_A); }
            if (!pe) { PG8_WAIT_V(8); } PG8_WAIT_L(0); PG8_BAR; PG8_MMA(0, 0, At, B0); PG8_MMA(0, 1, At, B1); PG8_BAR; PG8_SCHED;
            PG8_LDA(At, 0, 1); PG8_STAGE_T(PG8_SB(0, 0), b2, voffB, AUX_B); PG8_STAGE_T(PG8_SB(0, 1), b2 + hstep, voffB, AUX_B); PG8_STAGE_T(PG8_SA(0, 0), a2, voffA, AUX_A);
            if (!pe) { PG8_WAIT_V(8); } PG8_WAIT_L(0); PG8_BAR; PG8_MMA(1, 0, At, B0); PG8_MMA(1, 1, At, B1); PG8_BAR; PG8_SCHED;
            PG8_LDB(B0, 1, 0); PG8_LDB(B1, 1, 1); PG8_SCHED; PG8_LDA(At, 1, 0); PG8_STAGE_T(PG8_SA(0, 1), a2 + hstep, voffA, AUX_A);
            if (!pe) { PG8_WAIT_V(8); } PG8_WAIT_L(0); PG8_BAR; PG8_MMA(0, 0, At, B0); PG8_MMA(0, 1, At, B1); PG8_BAR; PG8_SCHED;
            PG8_LDA(At, 1, 1); PG8_STAGE_T(PG8_SB(1, 0), b3, voffB, AUX_B); PG8_STAGE_T(PG8_SB(1, 1), b3 + hstep, voffB, AUX_B); PG8_STAGE_T(PG8_SA(1, 0), a3, voffA, AUX_A);
            PG8_WAIT_V(8); PG8_WAIT_L(0); PG8_BAR; PG8_MMA(1, 0, At, B0); PG8_MMA(1, 1, At, B1); PG8_BAR; PG8_SCHED;
            } else {
            PG8_LDB(B0, 0, 0); PG8_SCHED; PG8_LDA(At, 0, 0); PG8_STAGE_T(PG8_SA(1, 1), a1 + hstep, voffA, AUX_A);
            PG8_WAIT_L(8); PG8_BAR; PG8_WAIT_L(0); PG8_MMA(0, 0, At, B0); PG8_BAR; PG8_SCHED;
            PG8_LDB(B1, 0, 1); PG8_STAGE_T(PG8_SB(0, 0), b2, voffB, AUX_B);
            PG8_BAR; PG8_WAIT_L(0); PG8_MMA(0, 1, At, B1); PG8_BAR;
            PG8_LDA(At, 0, 1); PG8_STAGE_T(PG8_SA(0, 0), a2, voffA, AUX_A);
            PG8_BAR; PG8_WAIT_L(0); PG8_MMA(1, 0, At, B0); PG8_BAR; PG8_SCHED;
            PG8_STAGE_T(PG8_SB(0, 1), b2 + hstep, voffB, AUX_B);
            PG8_WAIT_V(6); PG8_BAR; PG8_MMA(1, 1, At, B1); PG8_BAR;
            PG8_LDB(B0, 1, 0); PG8_SCHED; PG8_LDA(At, 1, 0); PG8_STAGE_T(PG8_SA(0, 1), a2 + hstep, voffA, AUX_A);
            PG8_WAIT_L(8); PG8_BAR; PG8_WAIT_L(0); PG8_MMA(0, 0, At, B0); PG8_BAR; PG8_SCHED;
            PG8_LDB(B1, 1, 1); PG8_STAGE_T(PG8_SB(1, 0), b3, voffB, AUX_B);
            PG8_BAR; PG8_WAIT_L(0); PG8_MMA(0, 1, At, B1); PG8_BAR;
            PG8_LDA(At, 1, 1); PG8_STAGE_T(PG8_SA(1, 0), a3, voffA, AUX_A);
            PG8_BAR; PG8_WAIT_L(0); PG8_MMA(1, 0, At, B0); PG8_BAR; PG8_SCHED;
            PG8_STAGE_T(PG8_SB(1, 1), b3 + hstep, voffB, AUX_B);
            PG8_WAIT_V(6); PG8_BAR; PG8_MMA(1, 1, At, B1); PG8_BAR;
            }
        }
        if constexpr (ALIGN_EPI) { if (wr == 0) PG8_BAR; }
        if constexpr (PEEL) { static_assert(ALIGN_EPI && SP2, "PEEL is written for the aligned two-super-phase loop");
            PG8_STAGE_T(PG8_SA(1, 1), nA + nk + hstep, voffA, AUX_A); }
        if constexpr (!Epi::AFTER_DRAIN) { E(acc, cur, wr, wc, fr, fq); S.done(cur); }
        if (!has_next) break;
        if constexpr (PEEL) { PG8_WAIT_V(8); }
#pragma unroll
        for (int a = 0; a < 2; ++a)
#pragma unroll
            for (int b = 0; b < 2; ++b)
#pragma unroll
                for (int m = 0; m < 4; ++m)
#pragma unroll
                    for (int n = 0; n < 2; ++n) acc[a][b][m][n] = (f32x4){0.f, 0.f, 0.f, 0.f};
        cur = nxt; cA = nA; cB = nB; ck = nk; ++ui;
        if constexpr (ALIGN_EPI) { if (wr == 1) PG8_BAR; }
    }
    PG8_WAIT_V(0);
    if constexpr (!ALIGN_EPI) { if (wr == 0) PG8_BAR; }
    PG8_BAR;
    if constexpr (Epi::AFTER_DRAIN) { E.fused(acc, cur, wr, wc, fr, fq, lds, wid, lane); S.done(cur); }
#undef PG8_SA
#undef PG8_SB
#undef PG8_STAGE_T
#undef PG8_LDA
#undef PG8_LDB
#undef PG8_MMA
#undef PG8_WAIT_V
#undef PG8_WAIT_L
#undef PG8_BAR
#undef PG8_SCHED
}
}

#define LAS __attribute__((address_space(3)))
typedef unsigned short bf16;
typedef unsigned v4u __attribute__((ext_vector_type(4)));
typedef unsigned v2u __attribute__((ext_vector_type(2)));
typedef float f32x4 __attribute__((ext_vector_type(4)));
typedef short bf16x8 __attribute__((ext_vector_type(8)));

#ifndef MK_N_LAUNCHES
#define MK_N_LAUNCHES 1
#endif
constexpr int N_PHASES = 15;
#ifndef ALIGN_GU
#define ALIGN_GU true
#endif
#ifndef PEELK
#define PEELK false
#endif
#ifndef ZZ
#define ZZ false
#endif
#ifndef NT_WIDE
#define NT_WIDE 0
#endif
#ifndef NT_NARROW
#define NT_NARROW 0
#endif
constexpr int NWAVES = 8;
constexpr int M = 32768, D = 1024, FF = 2816, DIN = 5120, DPLE = 256;
constexpr float EPS = 1e-6f;
constexpr size_t MiB = 1u << 20;
constexpr size_t WS_WGU1 = 0 * MiB;
constexpr size_t WS_WD1 = 11 * MiB;
constexpr size_t WS_WIN = 17 * MiB;
constexpr size_t WS_WOA = 27 * MiB, WS_WOB = 29 * MiB, WS_WO = 31 * MiB;
constexpr size_t WS_WGU2 = 33 * MiB, WS_WD2 = 44 * MiB;
constexpr size_t WS_WPG = 50 * MiB;
constexpr size_t WS_WPP = 52 * MiB;
constexpr size_t WS_PWT = 53 * MiB;
constexpr size_t WS_SGW = 54 * MiB;
constexpr size_t WS_PART = 55 * MiB;
constexpr size_t WS_CTL = 57 * MiB, CTL_BYTES = 16384;
constexpr size_t WS_RS = 57 * MiB + 65536;
constexpr size_t WS_PB = 58 * MiB;
constexpr size_t WS_SLAB = 80 * MiB, SLAB = 64 * MiB;
constexpr size_t WS_END = WS_SLAB + 6 * SLAB;
constexpr int LDS_BYTES = 147456, MISC_OFF = 147392, RS_TAB_OFF = 131072, RS_KEY_OFF = 131072 + 4096;

__device__ __forceinline__ float bf_lo(unsigned w) { return __uint_as_float(w << 16); }
__device__ __forceinline__ float bf_hi(unsigned w) { return __uint_as_float(w & 0xffff0000u); }
typedef __bf16 bf16x2_t __attribute__((ext_vector_type(2)));
typedef float f32x2_t __attribute__((ext_vector_type(2)));
__device__ __forceinline__ unsigned pk2(float lo, float hi) { bf16x2_t r = __builtin_convertvector((f32x2_t){lo, hi}, bf16x2_t); return __builtin_bit_cast(unsigned, r); }
#ifndef WT_STORES
#define WT_STORES 0
#endif
__device__ __forceinline__ void st16_wt(void* p, v4u v) {
#if WT_STORES
    asm volatile("s_nop 1\n\tglobal_store_dwordx4 %0, %1, off sc1" :: "v"(p), "v"(v) : "memory");
#else
    *(v4u*)p = v;
#endif
}
__device__ __forceinline__ void st8_wt(void* p, v2u v) {
#if WT_STORES
    asm volatile("s_nop 1\n\tglobal_store_dwordx2 %0, %1, off sc1" :: "v"(p), "v"(v) : "memory");
#else
    *(v2u*)p = v;
#endif
}
__device__ __forceinline__ void st4_wt(void* p, float v) {
#if WT_STORES
    asm volatile("s_nop 1\n\tglobal_store_dword %0, %1, off sc1" :: "v"(p), "v"(v) : "memory");
#else
    *(float*)p = v;
#endif
}
__device__ __forceinline__ float sigmoid_fast(float x) { return __builtin_amdgcn_rcpf(1.0f + __builtin_amdgcn_exp2f(-1.44269504089f * x)); }
__device__ __forceinline__ float gelu_tanh(float x) { return x * sigmoid_fast(1.5957691216f * (x + 0.044715f * x * x * x)); }
__device__ __forceinline__ float wave_sum(float v) {
#pragma unroll
    for (int o = 1; o < 64; o <<= 1) v += __shfl_xor(v, o);
    return v;
}


__device__ __forceinline__ void rs_table_fill(LAS unsigned char* lds, const pg8::StaticOrder& S, const float* rs) {
    int k0 = -1, k1 = -1, k2 = -1, k3 = -1;
    for (int i = 0;; ++i) { pg8::Unit u; if (!S.next(i, u)) break; const int pm = u.pm;
        if (pm != k0 && pm != k1 && pm != k2 && pm != k3) { if (k0 < 0) k0 = pm; else if (k1 < 0) k1 = pm; else if (k2 < 0) k2 = pm; else if (k3 < 0) k3 = pm; } }
    const int tid = threadIdx.x;
    LAS float* tab = (LAS float*)(lds + RS_TAB_OFF); LAS int* keys = (LAS int*)(lds + RS_KEY_OFF);
    if (tid < 256) {
        if (k0 >= 0) tab[tid] = rs[k0 * 256 + tid];
        if (k1 >= 0) tab[256 + tid] = rs[k1 * 256 + tid];
        if (k2 >= 0) tab[512 + tid] = rs[k2 * 256 + tid];
        if (k3 >= 0) tab[768 + tid] = rs[k3 * 256 + tid];
    }
    if (tid == 0) { keys[0] = k0; keys[1] = k1; keys[2] = k2; keys[3] = k3; }
    __syncthreads();
}
__device__ __forceinline__ void rs_rows(const LAS unsigned char* lds, const float* rs, int pm, int wr, int fr, float (&rv)[2][4]) {
    const LAS int* keys = (const LAS int*)(lds + RS_KEY_OFF); const LAS float* tab = (const LAS float*)(lds + RS_TAB_OFF);
    const int k0 = keys[0], k1 = keys[1], k2 = keys[2], k3 = keys[3];
    const int idx = (pm == k0) ? 0 : (pm == k1) ? 1 : (pm == k2) ? 2 : (pm == k3) ? 3 : -1;
    const int rl = wr * 64 + fr;
    if (idx >= 0) {
#pragma unroll
        for (int ai = 0; ai < 2; ++ai)
#pragma unroll
            for (int m = 0; m < 4; ++m) rv[ai][m] = tab[idx * 256 + rl + ai * 128 + m * 16];
    } else {
#pragma unroll
        for (int ai = 0; ai < 2; ++ai)
#pragma unroll
            for (int m = 0; m < 4; ++m) rv[ai][m] = rs[pm * 256 + rl + ai * 128 + m * 16];
    }
}
struct EpiGU {
    static constexpr bool PERM = true, AFTER_DRAIN = false;
    bf16* O; const float* rs; const LAS unsigned char* lds;
    __device__ __forceinline__ void operator()(const pg8::f32x4 (&acc)[2][2][4][2], const pg8::Unit& u, int wr, int wc, int fr, int fq) const {
        const int row0 = u.pm * 256 + wr * 64 + fr, col0 = u.pn * 128 + wc * 32 + 8 * fq;
        float rvs[2][4]; rs_rows(lds, rs, u.pm, wr, fr, rvs);
#pragma unroll
        for (int ai = 0; ai < 2; ++ai)
#pragma unroll
            for (int m = 0; m < 4; ++m) {
                const float rv = rvs[ai][m];
                bf16* p = O + (size_t)(row0 + ai * 128 + m * 16) * FF + col0;
                const pg8::f32x4 g0 = acc[ai][0][m][0] * rv, g1 = acc[ai][0][m][1] * rv, u0 = acc[ai][1][m][0] * rv, u1 = acc[ai][1][m][1] * rv;
                float r[8];
#pragma unroll
                for (int j = 0; j < 4; ++j) { r[j] = g0[j] * sigmoid_fast(g0[j]) * u0[j]; r[4 + j] = g1[j] * sigmoid_fast(g1[j]) * u1[j]; }
                v4u w; w.x = pk2(r[0], r[1]); w.y = pk2(r[2], r[3]); w.z = pk2(r[4], r[5]); w.w = pk2(r[6], r[7]);
                __builtin_nontemporal_store(w, (v4u*)p);
            }
    }
};
template <int ACT  , bool GATE, bool ADD, bool PART, bool RSCALE = false> struct EpiN {
    static constexpr bool PERM = true, AFTER_DRAIN = false;
    bf16* O; const bf16* G; const bf16* A2; float* part; const float* rs; const LAS unsigned char* lds;
    __device__ __forceinline__ void operator()(const pg8::f32x4 (&acc)[2][2][4][2], const pg8::Unit& u, int wr, int wc, int fr, int fq) const {
        const int row0 = u.pm * 256 + wr * 64 + fr, col0 = u.pn * 256 + wc * 32 + 8 * fq;
        float rvs[2][4];
        if (RSCALE) rs_rows(lds, rs, u.pm, wr, fr, rvs);
#pragma unroll
        for (int ai = 0; ai < 2; ++ai) {
            v4u gq[4][2], aq[4][2];
            if (GATE) {
#pragma unroll
                for (int m = 0; m < 4; ++m)
#pragma unroll
                    for (int bj = 0; bj < 2; ++bj) gq[m][bj] = *(const v4u*)(G + (size_t)(row0 + ai * 128 + m * 16) * D + col0 + bj * 128);
            }
            if (ADD) {
#pragma unroll
                for (int m = 0; m < 4; ++m)
#pragma unroll
                    for (int bj = 0; bj < 2; ++bj) aq[m][bj] = *(const v4u*)(A2 + (size_t)(row0 + ai * 128 + m * 16) * D + col0 + bj * 128);
            }
#pragma unroll
            for (int m = 0; m < 4; ++m) {
                const int row = row0 + ai * 128 + m * 16;
                const size_t off = (size_t)row * D + col0;
                float s = 0.f;
#pragma unroll
                for (int bj = 0; bj < 2; ++bj) {
                    float r[8];
#pragma unroll
                    for (int j = 0; j < 4; ++j) { r[j] = acc[ai][bj][m][0][j]; r[4 + j] = acc[ai][bj][m][1][j]; }
                    if (RSCALE) { const float rv = rvs[ai][m];
#pragma unroll
                        for (int j = 0; j < 8; ++j) r[j] *= rv; }
                    if (ACT == 1) {
#pragma unroll
                        for (int j = 0; j < 8; ++j) r[j] = sigmoid_fast(r[j]);
                    }
                    if (GATE) { const v4u g = gq[m][bj];
                        r[0] *= bf_lo(g.x); r[1] *= bf_hi(g.x); r[2] *= bf_lo(g.y); r[3] *= bf_hi(g.y); r[4] *= bf_lo(g.z); r[5] *= bf_hi(g.z); r[6] *= bf_lo(g.w); r[7] *= bf_hi(g.w); }
                    if (ADD) { const v4u g = aq[m][bj];
                        r[0] += bf_lo(g.x); r[1] += bf_hi(g.x); r[2] += bf_lo(g.y); r[3] += bf_hi(g.y); r[4] += bf_lo(g.z); r[5] += bf_hi(g.z); r[6] += bf_lo(g.w); r[7] += bf_hi(g.w); }
                    if (PART) {
#pragma unroll
                        for (int j = 0; j < 8; ++j) s += r[j] * r[j];
                    }
                    v4u w; w.x = pk2(r[0], r[1]); w.y = pk2(r[2], r[3]); w.z = pk2(r[4], r[5]); w.w = pk2(r[6], r[7]);
                    st16_wt(O + off + bj * 128, w);
                }
                if (PART) { s += __shfl_xor(s, 16); s += __shfl_xor(s, 32); st4_wt(part + (size_t)row * 16 + u.pn * 4 + wc, s); }
            }
            if (GATE || ADD) asm volatile("" ::: "memory");
        }
    }
};
struct EpiIn {
    static constexpr bool PERM = true, AFTER_DRAIN = false;
    bf16* base; const float* rs; const LAS unsigned char* lds;
    __device__ __forceinline__ void operator()(const pg8::f32x4 (&acc)[2][2][4][2], const pg8::Unit& u, int wr, int wc, int fr, int fq) const {
        float rvs[2][4]; rs_rows(lds, rs, u.pm, wr, fr, rvs);
        const int t = u.pn >> 2;
        bf16* O = base + (size_t)t * (SLAB / 2);
        const int row0 = u.pm * 256 + wr * 64 + fr, col0 = (u.pn & 3) * 256 + wc * 32 + 8 * fq;
#pragma unroll
        for (int ai = 0; ai < 2; ++ai)
#pragma unroll
            for (int m = 0; m < 4; ++m) {
                const size_t off = (size_t)(row0 + ai * 128 + m * 16) * D + col0;
                const float rv = rvs[ai][m];
#pragma unroll
                for (int bj = 0; bj < 2; ++bj) {
                    float r[8];
#pragma unroll
                    for (int j = 0; j < 4; ++j) { r[j] = acc[ai][bj][m][0][j] * rv; r[4 + j] = acc[ai][bj][m][1][j] * rv; }
                    if (t < 2) {
#pragma unroll
                        for (int j = 0; j < 8; ++j) r[j] = gelu_tanh(r[j]);
                    } else if (t > 2) {
#pragma unroll
                        for (int j = 0; j < 8; ++j) r[j] = sigmoid_fast(r[j]);
                    }
                    v4u w; w.x = pk2(r[0], r[1]); w.y = pk2(r[2], r[3]); w.z = pk2(r[4], r[5]); w.w = pk2(r[6], r[7]);
                    __builtin_nontemporal_store(w, (v4u*)(O + off + bj * 128));
                }
            }
    }
};

template <bool HASG> __device__ __forceinline__ void transpose_item(const float* W, int K, int N, bf16* WT, int k0, int n0, int orow0, const float* gk, LAS float* scr, int lane) {
    float w[32], gv[32];
    const float* src = W + (size_t)(k0 + (lane >> 5)) * N + n0 + (lane & 31);
#pragma unroll
    for (int i = 0; i < 32; ++i) w[i] = __builtin_nontemporal_load(src + (size_t)(2 * i) * N);
    if (HASG) {
#pragma unroll
        for (int i = 0; i < 32; ++i) gv[i] = gk[k0 + 2 * i + (lane >> 5)];
    }
#pragma unroll
    for (int i = 0; i < 32; ++i) { const int kk = 2 * i + (lane >> 5); scr[kk * 33 + (lane & 31)] = HASG ? w[i] * gv[i] : w[i]; }
    asm volatile("s_waitcnt lgkmcnt(0)" ::: "memory");
    const int c = lane & 7;
#pragma unroll
    for (int j = 0; j < 4; ++j) { const int n = (lane >> 3) + 8 * j; const LAS float* s = scr + (8 * c) * 33 + n;
        v4u o; o.x = pk2(s[0 * 33], s[1 * 33]); o.y = pk2(s[2 * 33], s[3 * 33]); o.z = pk2(s[4 * 33], s[5 * 33]); o.w = pk2(s[6 * 33], s[7 * 33]);
        *(v4u*)(WT + (size_t)(orow0 + n) * K + k0 + 8 * c) = o; }
    asm volatile("s_waitcnt lgkmcnt(0)" ::: "memory");
}
template <bool HASG> __device__ __forceinline__ bool transpose_mat(int& r, const float* W, int K, int N, bf16* WT, int mode, const float* gk, LAS float* scr, int lane) {
    const int nblk = N / 32, cnt = (K / 64) * nblk;
    if (r >= cnt) { r -= cnt; return false; }
    const int kb = r / nblk, nb = r % nblk, n0 = 32 * nb;
    const int orow0 = mode < 0 ? n0 : 256 * (n0 >> 7) + (n0 & 127) + 128 * mode;
    transpose_item<HASG>(W, K, N, WT, 64 * kb, n0, orow0, gk, scr, lane);
    return true;
}
__device__ __forceinline__ void xrow_load(f32x4 (&v)[4][4], const float* x, int rb, int lane) {
#pragma unroll
    for (int i = 0; i < 4; ++i)
#pragma unroll
        for (int j = 0; j < 4; ++j) v[i][j] = __builtin_nontemporal_load((const f32x4*)(x + (size_t)(rb + i) * D) + lane + 64 * j);
}
__device__ __forceinline__ void xrow_store(const f32x4 (&v)[4][4], bf16* hb, float* rs_out, int rb, int lane) {
#pragma unroll
    for (int i = 0; i < 4; ++i) {
        float s = 0.f;
#pragma unroll
        for (int j = 0; j < 4; ++j) s += (v[i][j].x * v[i][j].x + v[i][j].y * v[i][j].y) + (v[i][j].z * v[i][j].z + v[i][j].w * v[i][j].w);
        const float tot = wave_sum(s);
        if (lane == 0) rs_out[rb + i] = 1.0f / sqrtf(tot * (1.f / D) + EPS);
        v2u* o8 = (v2u*)(hb + (size_t)(rb + i) * D) + lane;
#pragma unroll
        for (int j = 0; j < 4; ++j) { v2u o; o.x = pk2(v[i][j].x, v[i][j].y); o.y = pk2(v[i][j].z, v[i][j].w); o8[64 * j] = o; }
    }
}
__device__ __forceinline__ void x_rows_to_bf16(const float* x, bf16* hb, float* rs_out, int gw, int NGW, int lane) {
    constexpr int R = 4; const int step = NGW * R;
    f32x4 a[4][4], b[4][4];
    int rb = gw * R;
    if (rb < M) xrow_load(a, x, rb, lane);
#pragma unroll 1
    for (; rb < M; rb += 2 * step) {
        const int nb = rb + step, nb2 = nb + step;
        if (nb < M) xrow_load(b, x, nb, lane);
        xrow_store(a, hb, rs_out, rb, lane);
        if (nb2 < M) xrow_load(a, x, nb2, lane);
        if (nb < M) xrow_store(b, hb, rs_out, nb, lane);
    }
}
template <bool SRC_F32, int R> struct EwSet { float p[R]; v2u fw[R][4]; f32x4 h32[SRC_F32 ? R : 1][4]; v2u hb[SRC_F32 ? 1 : R][4]; };
template <bool SRC_F32, int R> __device__ __forceinline__ void ew_load(EwSet<SRC_F32, R>& S, int rb, const float* hsrc32, const bf16* hsrcb, const bf16* f, const float* part, int lane) {
#pragma unroll
    for (int i = 0; i < R; ++i) S.p[i] = (lane < 16) ? part[(size_t)(rb + i) * 16 + lane] : 0.f;
#pragma unroll
    for (int i = 0; i < R; ++i)
#pragma unroll
        for (int j = 0; j < 4; ++j) {
            S.fw[i][j] = ((const v2u*)(f + (size_t)(rb + i) * D) + lane)[64 * j];
            if constexpr (SRC_F32) S.h32[i][j] = __builtin_nontemporal_load((const f32x4*)(hsrc32 + (size_t)(rb + i) * D) + lane + 64 * j);
            else S.hb[i][j] = ((const v2u*)(hsrcb + (size_t)(rb + i) * D) + lane)[64 * j];
        }
}
template <bool SRC_F32, bool FINAL, int R> __device__ __forceinline__ void ew_compute(const EwSet<SRC_F32, R>& S, int rb, const f32x4 (&g)[4], bf16* hb_out, float* out32, float scale, float* rs_out, int lane) {
#pragma unroll
    for (int i = 0; i < R; ++i) {
        float q = S.p[i];
        q += __shfl_xor(q, 1); q += __shfl_xor(q, 2); q += __shfl_xor(q, 4); q += __shfl_xor(q, 8);
        const float ss = __shfl(q, 0);
        const float rs = scale / sqrtf(ss * (1.f / D) + EPS);
        float s2 = 0.f;
#pragma unroll
        for (int j = 0; j < 4; ++j) {
            f32x4 h;
            if constexpr (SRC_F32) h = S.h32[i][j];
            else { const v2u hw = S.hb[i][j]; h.x = bf_lo(hw.x); h.y = bf_hi(hw.x); h.z = bf_lo(hw.y); h.w = bf_hi(hw.y); }
            const v2u fw = S.fw[i][j];
            f32x4 v; v.x = h.x + bf_lo(fw.x) * rs * g[j].x; v.y = h.y + bf_hi(fw.x) * rs * g[j].y; v.z = h.z + bf_lo(fw.y) * rs * g[j].z; v.w = h.w + bf_hi(fw.y) * rs * g[j].w;
            if (FINAL) __builtin_nontemporal_store(v, (f32x4*)(out32 + (size_t)(rb + i) * D) + lane + 64 * j);
            else { v2u o; o.x = pk2(v.x, v.y); o.y = pk2(v.z, v.w); ((v2u*)(hb_out + (size_t)(rb + i) * D) + lane)[64 * j] = o; s2 += (v.x * v.x + v.y * v.y) + (v.z * v.z + v.w * v.w); }
        }
        if (!FINAL) { const float tot = wave_sum(s2); if (lane == 0) rs_out[rb + i] = 1.0f / sqrtf(tot * (1.f / D) + EPS); }
    }
}
template <bool SRC_F32, bool FINAL> __device__ __forceinline__ void ew_phase(const float* hsrc32, const bf16* hsrcb, bf16* hb_out, float* out32, const bf16* f, const float* part, const float* gpost, float scale, float* rs_out, int gw, int NGW, int lane) {
    constexpr int R = SRC_F32 ? 2 : 4;
    f32x4 g[4];
#pragma unroll
    for (int j = 0; j < 4; ++j) g[j] = ((const f32x4*)gpost + lane)[64 * j];
    const int step = NGW * R;
    EwSet<SRC_F32, R> A, B;
    int rb = gw * R;
    if (rb < M) ew_load<SRC_F32, R>(A, rb, hsrc32, hsrcb, f, part, lane);
#pragma unroll 1
    for (; rb < M; rb += 2 * step) {
        const int nb = rb + step, nb2 = nb + step;
        if (nb < M) ew_load<SRC_F32, R>(B, nb, hsrc32, hsrcb, f, part, lane);
        ew_compute<SRC_F32, FINAL, R>(A, rb, g, hb_out, out32, scale, rs_out, lane);
        if (nb2 < M) ew_load<SRC_F32, R>(A, nb2, hsrc32, hsrcb, f, part, lane);
        if (nb < M) ew_compute<SRC_F32, FINAL, R>(B, nb, g, hb_out, out32, scale, rs_out, lane);
    }
}

constexpr int MX_WS_PITCH = 272, MX_T_PITCH = 528, MX_T_OFF = 75520, MX_STAT_OFF = MX_T_OFF + 128 * MX_T_PITCH  ;
__device__ __forceinline__ void unpack8(const v4u w, float (&x)[8]) { x[0] = bf_lo(w.x); x[1] = bf_hi(w.x); x[2] = bf_lo(w.y); x[3] = bf_hi(w.y); x[4] = bf_lo(w.z); x[5] = bf_hi(w.z); x[6] = bf_lo(w.w); x[7] = bf_hi(w.w); }
__device__ __forceinline__ void mixer_phase(LAS unsigned char* lds, bf16* U  , const bf16* V, const bf16* C, bf16* Bout,
                                            const bf16* wsb, const float* sgu_b, const float* sgu_g, const bf16* pwT, const float* pool_scale, int G, int bid) {
    const int tid = threadIdx.x, wid = __builtin_amdgcn_readfirstlane(tid >> 6), lane = tid & 63, fr = lane & 15, fq = lane >> 4;
    LAS float* stat = (LAS float*)(lds + MX_STAT_OFF);
    for (int q = bid; q < M / 128; q += G) {
        const int r0 = q * 128;
#pragma unroll 1
        for (int ib = 0; ib < 16; ib += 4) {
            v4u raw[4][2];
#pragma unroll
            for (int i = 0; i < 4; ++i) { const v4u* vr = (const v4u*)(V + (size_t)(r0 + wid * 16 + ib + i) * D); raw[i][0] = vr[lane]; raw[i][1] = vr[lane + 64]; }
#pragma unroll
            for (int i = 0; i < 4; ++i) {
                float x[16]; { float a[8], b[8]; unpack8(raw[i][0], a); unpack8(raw[i][1], b);
#pragma unroll
                    for (int j = 0; j < 8; ++j) { x[j] = a[j]; x[8 + j] = b[j]; } }
                float sm = 0.f;
#pragma unroll
                for (int j = 0; j < 16; ++j) sm += x[j];
                const float mean = wave_sum(sm) * (1.f / D);
                float sq = 0.f;
#pragma unroll
                for (int j = 0; j < 16; ++j) { const float d = x[j] - mean; sq += d * d; }
                const float rstd = 1.0f / sqrtf(wave_sum(sq) * (1.f / D) + EPS);
                if (lane == 0) { const int sr = wid * 16 + ib + i; stat[2 * sr] = mean; stat[2 * sr + 1] = rstd; }
            }
        }
        __syncthreads();
#pragma unroll 1
        for (int g = 0; g < 4; ++g) {
            {
                v4u wv[4], vv[8];
#pragma unroll
                for (int i = 0; i < 4; ++i) { const int id = tid + 512 * i; wv[i] = *(const v4u*)(wsb + (size_t)g * 16384 + (id >> 4) * 128 + (id & 15) * 8); }
                const int c8 = tid & 31;
#pragma unroll
                for (int i = 0; i < 8; ++i) vv[i] = *(const v4u*)(V + (size_t)(r0 + (tid >> 5) + 16 * i) * D + g * 256 + c8 * 8);
                const f32x4 g0 = *(const f32x4*)(sgu_g + g * 256 + c8 * 8), g1 = *(const f32x4*)(sgu_g + g * 256 + c8 * 8 + 4);
#pragma unroll
                for (int i = 0; i < 4; ++i) { const int id = tid + 512 * i; *(LAS v4u*)(lds + (id >> 4) * MX_WS_PITCH + (id & 15) * 16) = wv[i]; }
#pragma unroll
                for (int i = 0; i < 8; ++i) { const int sr = (tid >> 5) + 16 * i;
                    float x[8]; unpack8(vv[i], x);
                    const float mean = stat[2 * sr], rstd = stat[2 * sr + 1];
                    v4u w; w.x = pk2((x[0] - mean) * rstd * g0.x, (x[1] - mean) * rstd * g0.y); w.y = pk2((x[2] - mean) * rstd * g0.z, (x[3] - mean) * rstd * g0.w);
                    w.z = pk2((x[4] - mean) * rstd * g1.x, (x[5] - mean) * rstd * g1.y); w.w = pk2((x[6] - mean) * rstd * g1.z, (x[7] - mean) * rstd * g1.w);
                    *(LAS v4u*)(lds + MX_T_OFF + sr * MX_T_PITCH + c8 * 16) = w; }
            }
            __syncthreads();
            v4u uu[8];
#pragma unroll
            for (int m = 0; m < 8; ++m) uu[m] = *(const v4u*)(U + (size_t)(r0 + 16 * m + fr) * D + g * 256 + 32 * wid + 8 * fq);
            f32x4 acc[8][2];
#pragma unroll
            for (int m = 0; m < 8; ++m) { acc[m][0] = (f32x4){0.f, 0.f, 0.f, 0.f}; acc[m][1] = (f32x4){0.f, 0.f, 0.f, 0.f}; }
            const int dch = 32 * wid + 8 * (fr >> 2) + (fr & 3);
#pragma unroll 1
            for (int k = 0; k < 4; ++k) {
                bf16x8 vf[2];
#pragma unroll
                for (int n = 0; n < 2; ++n)
#pragma unroll
                    for (int i = 0; i < 8; ++i) vf[n][i] = *(const LAS short*)(lds + MX_T_OFF + (32 * k + 8 * fq + i) * MX_T_PITCH + (dch + 4 * n) * 2);
#pragma unroll
                for (int m = 0; m < 8; ++m) {
                    if (16 * m + 15 >= 32 * k) {
                        const bf16x8 wf = *(const LAS bf16x8*)(lds + (16 * m + fr) * MX_WS_PITCH + (32 * k + 8 * fq) * 2);
                        acc[m][0] = __builtin_amdgcn_mfma_f32_16x16x32_bf16(vf[0], wf, acc[m][0], 0, 0, 0);
                        acc[m][1] = __builtin_amdgcn_mfma_f32_16x16x32_bf16(vf[1], wf, acc[m][1], 0, 0, 0);
                    }
                }
            }
#pragma unroll
            for (int m = 0; m < 8; ++m) {
                const int t = 16 * m + fr; const float bias = sgu_b[g * 128 + t];
                bf16* up = U + (size_t)(r0 + t) * D + g * 256 + 32 * wid + 8 * fq;
                float x[8]; unpack8(uu[m], x);
                v4u w; w.x = pk2(x[0] * (acc[m][0][0] + bias), x[1] * (acc[m][0][1] + bias)); w.y = pk2(x[2] * (acc[m][0][2] + bias), x[3] * (acc[m][0][3] + bias));
                w.z = pk2(x[4] * (acc[m][1][0] + bias), x[5] * (acc[m][1][1] + bias)); w.w = pk2(x[6] * (acc[m][1][2] + bias), x[7] * (acc[m][1][3] + bias));
                st16_wt(up, w);
            }
            __syncthreads();
        }
#pragma unroll 1
        for (int gi = 0; gi < 4; ++gi) {
            const int w = 2 << gi;
            bf16x8 pf[8][2];
            { const bf16* pw = pwT + (size_t)gi * 65536 + (size_t)(32 * wid + 8 * (fr >> 2) + (fr & 3)) * 256 + 8 * fq;
#pragma unroll
              for (int k = 0; k < 8; ++k) { pf[k][0] = *(const bf16x8*)(pw + 32 * k); pf[k][1] = *(const bf16x8*)(pw + 4 * 256 + 32 * k); } }
            {
                const bool has_hist = (q & 31) != 0;
                v4u cv[9];
#pragma unroll
                for (int i = 0; i < 9; ++i) { const int id = tid + 512 * i, row = id >> 5, c8 = id & 31;
                    cv[i] = (v4u){0u, 0u, 0u, 0u};
                    if (id < 143 * 32 && (row >= 15 || has_hist)) cv[i] = *(const v4u*)(C + ((ptrdiff_t)r0 + row - 15) * D + gi * 256 + c8 * 8); }
#pragma unroll
                for (int i = 0; i < 9; ++i) { const int id = tid + 512 * i, row = id >> 5, c8 = id & 31;
                    if (id < 143 * 32) *(LAS v4u*)(lds + row * MX_T_PITCH + c8 * 16) = cv[i]; }
            }
            __syncthreads();
            {
                const int c8 = tid & 31, t0 = (tid >> 5) * 8, pos0 = (q & 31) * 128 + t0;
                const LAS unsigned char* rp = lds + (t0 + 15) * MX_T_PITCH + c8 * 16;
                float S[8];
#pragma unroll
                for (int e = 0; e < 8; ++e) S[e] = 0.f;
                for (int j = 1; j < w; ++j) { float x[8]; unpack8(*(const LAS v4u*)(rp - j * MX_T_PITCH), x);
#pragma unroll
                    for (int e = 0; e < 8; ++e) S[e] += x[e]; }
#pragma unroll
                for (int i = 0; i < 8; ++i) {
                    const int pos = pos0 + i;
                    float x[8], y[8]; unpack8(*(const LAS v4u*)(rp + i * MX_T_PITCH), x); unpack8(*(const LAS v4u*)(rp + (i - w + 1) * MX_T_PITCH), y);
                    const float inv = 1.0f / (float)(pos + 1 < w ? pos + 1 : w);
                    float d[8];
#pragma unroll
                    for (int e = 0; e < 8; ++e) { S[e] += x[e]; d[e] = S[e] * inv - x[e]; S[e] -= y[e]; }
                    v4u o; o.x = pk2(d[0], d[1]); o.y = pk2(d[2], d[3]); o.z = pk2(d[4], d[5]); o.w = pk2(d[6], d[7]);
                    *(LAS v4u*)(lds + MX_T_OFF + (t0 + i) * MX_T_PITCH + c8 * 16) = o;
                }
            }
            __syncthreads();
            f32x4 acc[8][2];
#pragma unroll
            for (int m = 0; m < 8; ++m) { acc[m][0] = (f32x4){0.f, 0.f, 0.f, 0.f}; acc[m][1] = (f32x4){0.f, 0.f, 0.f, 0.f}; }
#pragma unroll
            for (int k = 0; k < 8; ++k) {
#pragma unroll
                for (int m = 0; m < 8; ++m) {
                    const bf16x8 df = *(const LAS bf16x8*)(lds + MX_T_OFF + (16 * m + fr) * MX_T_PITCH + (32 * k + 8 * fq) * 2);
                    acc[m][0] = __builtin_amdgcn_mfma_f32_16x16x32_bf16(pf[k][0], df, acc[m][0], 0, 0, 0);
                    acc[m][1] = __builtin_amdgcn_mfma_f32_16x16x32_bf16(pf[k][1], df, acc[m][1], 0, 0, 0);
                }
            }
            {
                const int ch = gi * 256 + 32 * wid + 8 * fq;
                const f32x4 s0 = *(const f32x4*)(pool_scale + ch), s1 = *(const f32x4*)(pool_scale + ch + 4);
#pragma unroll
                for (int m = 0; m < 8; ++m) {
                    const int t = 16 * m + fr;
                    v4u o; o.x = pk2(acc[m][0][0] * s0.x, acc[m][0][1] * s0.y); o.y = pk2(acc[m][0][2] * s0.z, acc[m][0][3] * s0.w);
                    o.z = pk2(acc[m][1][0] * s1.x, acc[m][1][1] * s1.y); o.w = pk2(acc[m][1][2] * s1.z, acc[m][1][3] * s1.w);
                    st16_wt(Bout + (size_t)(r0 + t) * D + ch, o);
                }
            }
            __syncthreads();
        }
    }
}

#define XB_TMO      128
#define XB_XCNT(j)  (256  + 64 * (j))
#define XB_XSUB(j)  (1280 + 64 * (j))
#define XB_XGEN(j)  (2304 + 64 * (j))
#define XB_TOP      3328
#define XB_TOPGEN   3392
#define XCD_BAR_WORDS 3456
#define XB_SPIN_CAP (1u << 18)

__device__ __forceinline__ unsigned xb_ld(unsigned* p)              { return __hip_atomic_load(p, __ATOMIC_RELAXED, __HIP_MEMORY_SCOPE_AGENT); }
__device__ __forceinline__ unsigned xb_add(unsigned* p, unsigned v) { return __hip_atomic_fetch_add(p, v, __ATOMIC_RELAXED, __HIP_MEMORY_SCOPE_AGENT); }
__device__ __forceinline__ unsigned xb_xcc_id() { return (unsigned)__builtin_amdgcn_s_getreg((3 << 11) | 20) & 0xFu; }
#define XB_SPIN(cond, bar) do { unsigned _sp = 0; while (cond) { __builtin_amdgcn_s_sleep(1); \
    if ((++_sp & 255u) == 0u) { if (xb_ld(&(bar)[XB_TMO])) break; if (_sp > XB_SPIN_CAP) { atomicAdd(&(bar)[XB_TMO], 1u); break; } } } } while (0)

struct XcdBarrier {
    unsigned* bar; unsigned x;
    volatile LAS unsigned* st;
};

__device__ __forceinline__ XcdBarrier xcd_barrier_post(unsigned* bar, volatile LAS unsigned* st) {
    XcdBarrier b; b.bar = bar; b.x = xb_xcc_id(); b.st = st;
    if (threadIdx.x == 0) (void)xb_add(&bar[XB_XCNT(b.x)], 1u);
    return b;
}
__device__ __forceinline__ void xcd_barrier_complete(unsigned* bar, unsigned x, unsigned& nloc, unsigned& nx) {
    const unsigned G = gridDim.x * gridDim.y * gridDim.z;
    unsigned sum, cnt, mine, sp = 0u;
    for (;;) {
        sum = 0u; cnt = 0u; mine = 0u;
#pragma unroll
        for (unsigned j = 0; j < 16; ++j) { const unsigned c = xb_ld(&bar[XB_XCNT(j)]); sum += c; cnt += (c > 0u) ? 1u : 0u; mine = (j == x) ? c : mine; }
        if (sum == G) break;
        __builtin_amdgcn_s_sleep(1);
        if ((++sp & 255u) == 0u) { if (xb_ld(&bar[XB_TMO])) break; if (sp > XB_SPIN_CAP) { atomicAdd(&bar[XB_TMO], 1u); break; } }
    }
    nloc = mine > 0u ? mine : 1u; nx = cnt > 0u ? cnt : 1u;
}

__device__ __forceinline__ void xcd_barrier(const XcdBarrier& b) {
    asm volatile("s_waitcnt vmcnt(0)" ::: "memory");
    __syncthreads();
    if (threadIdx.x == 0) {
        unsigned* bar = b.bar;
        __builtin_amdgcn_s_waitcnt(0);
        unsigned nloc = b.st[0], nx = b.st[1];
        if (nloc == 0u) { xcd_barrier_complete(bar, b.x, nloc, nx); b.st[0] = nloc; b.st[1] = nx; }
        const unsigned old = xb_add(&bar[XB_XSUB(b.x)], 1u);
        const unsigned gen = old / nloc;
        if (old + 1u == (gen + 1u) * nloc) {
            __builtin_amdgcn_fence(__ATOMIC_RELEASE, "agent");
            asm volatile("s_waitcnt vmcnt(0)" ::: "memory");
            const unsigned og = xb_add(&bar[XB_TOP], 1u);
            const unsigned tg = og / nx;
            if (og + 1u == (tg + 1u) * nx) xb_add(&bar[XB_TOPGEN], 1u);
            else XB_SPIN(xb_ld(&bar[XB_TOPGEN]) == tg, bar);
            __builtin_amdgcn_fence(__ATOMIC_ACQUIRE, "agent");
            xb_add(&bar[XB_XGEN(b.x)], 1u);
            asm volatile("s_waitcnt vmcnt(0)" ::: "memory");
        } else {
            XB_SPIN(xb_ld(&bar[XB_XGEN(b.x)]) == gen, bar);
            __builtin_amdgcn_fence(__ATOMIC_ACQUIRE, "agent");
            asm volatile("s_waitcnt vmcnt(0)" ::: "memory");
        }
    }
    __syncthreads();
}


__device__ __forceinline__ int opq(int v) { asm volatile("" : "+s"(v)); return v; }
struct Args { const float* in[27]; float* out; unsigned char* ws; int ph_lo, ph_hi; };
enum { I_X = 0, I_P, I_F1PRE, I_F1G, I_F1U, I_F1D, I_F1POST, I_MIXPRE, I_WIN, I_SGUG, I_SGUW, I_SGUB, I_POOLW, I_POOLS, I_WOA, I_WOB, I_WO, I_MIXPOST,
       I_F2PRE, I_F2G, I_F2U, I_F2D, I_F2POST, I_PLEPRE, I_PLEG, I_PLEP, I_PLEPOST };

__global__ void __launch_bounds__(NWAVES * 64, 2) mk_fwd(Args a) {
    extern __shared__ __attribute__((aligned(16))) unsigned char lds_raw[];
    LAS unsigned char* lds = (LAS unsigned char*)lds_raw;
    const int tid = threadIdx.x, lane = tid & 63, wave = __builtin_amdgcn_readfirstlane(tid >> 6);
    const int G = gridDim.x, bid = blockIdx.x;
    const int gw = bid * NWAVES + wave, NGW = G * NWAVES;
    unsigned char* ws = a.ws;
    bf16* WGU1 = (bf16*)(ws + WS_WGU1); bf16* WD1 = (bf16*)(ws + WS_WD1); bf16* WIN = (bf16*)(ws + WS_WIN);
    bf16* WOA = (bf16*)(ws + WS_WOA); bf16* WOB = (bf16*)(ws + WS_WOB); bf16* WO = (bf16*)(ws + WS_WO);
    bf16* WGU2 = (bf16*)(ws + WS_WGU2); bf16* WD2 = (bf16*)(ws + WS_WD2); bf16* WPG = (bf16*)(ws + WS_WPG); bf16* WPP = (bf16*)(ws + WS_WPP);
    bf16* PWT = (bf16*)(ws + WS_PWT); bf16* SGW = (bf16*)(ws + WS_SGW); float* PART = (float*)(ws + WS_PART); bf16* PB = (bf16*)(ws + WS_PB);
    bf16* S0 = (bf16*)(ws + WS_SLAB); bf16* S1 = (bf16*)(ws + WS_SLAB + SLAB); bf16* S2 = (bf16*)(ws + WS_SLAB + 2 * SLAB);
    bf16* S3 = (bf16*)(ws + WS_SLAB + 3 * SLAB); bf16* S4 = (bf16*)(ws + WS_SLAB + 4 * SLAB); bf16* S5 = (bf16*)(ws + WS_SLAB + 5 * SLAB);
    bf16* XN = S0; bf16* ACT = S1; bf16* FB = S4;
    float* RS = (float*)(ws + WS_RS); bf16* HB = S0;
    bf16* BB = (bf16*)a.out;
    const int lo = a.ph_lo, hi = a.ph_hi;
#ifndef PH_MASK
#define PH_MASK 0x7fff
#endif
#define IN(k) (((PH_MASK >> (k)) & 1) && lo <= (k) && (k) < hi)
#ifndef DUP_MASK
#define DUP_MASK 0
#endif
#define NDUP(k) (1 + ((DUP_MASK >> (k)) & 1))
    if (tid < 2) ((LAS unsigned*)(lds + MISC_OFF))[tid] = 0u;
    __syncthreads();
    XcdBarrier xbar; xbar.bar = (unsigned*)(ws + WS_CTL); xbar.x = 0; xbar.st = nullptr;
    if (hi - lo > 1) xbar = xcd_barrier_post((unsigned*)(ws + WS_CTL), (volatile LAS unsigned*)(lds + MISC_OFF));
#define SEAM(k) do { if (IN(k) && IN((k) + 1)) { xcd_barrier(xbar); } } while (0)
    if (lo < 0) cg::this_grid().sync();

    if (IN(0)) {
        LAS float* scr = (LAS float*)(lds + wave * 16384);
        constexpr int NITEMS = 13312;
        for (int it = gw; it < NITEMS; it += NGW) {
            int r = it;
            if (transpose_mat<true>(r, a.in[I_F1G], D, FF, WGU1, 0, a.in[I_F1PRE], scr, lane)) continue;
            if (transpose_mat<true>(r, a.in[I_F1U], D, FF, WGU1, 1, a.in[I_F1PRE], scr, lane)) continue;
            if (transpose_mat<false>(r, a.in[I_F1D], FF, D, WD1, -1, nullptr, scr, lane)) continue;
            if (transpose_mat<true>(r, a.in[I_WIN], D, DIN, WIN, -1, a.in[I_MIXPRE], scr, lane)) continue;
            if (transpose_mat<false>(r, a.in[I_WOA], D, D, WOA, -1, nullptr, scr, lane)) continue;
            if (transpose_mat<false>(r, a.in[I_WOB], D, D, WOB, -1, nullptr, scr, lane)) continue;
            if (transpose_mat<false>(r, a.in[I_WO], D, D, WO, -1, nullptr, scr, lane)) continue;
            if (transpose_mat<true>(r, a.in[I_F2G], D, FF, WGU2, 0, a.in[I_F2PRE], scr, lane)) continue;
            if (transpose_mat<true>(r, a.in[I_F2U], D, FF, WGU2, 1, a.in[I_F2PRE], scr, lane)) continue;
            if (transpose_mat<false>(r, a.in[I_F2D], FF, D, WD2, -1, nullptr, scr, lane)) continue;
            if (transpose_mat<true>(r, a.in[I_PLEG], D, D, WPG, -1, a.in[I_PLEPRE], scr, lane)) continue;
            if (transpose_mat<false>(r, a.in[I_PLEP], DPLE, D, WPP, -1, nullptr, scr, lane)) continue;
            if (transpose_mat<false>(r, a.in[I_POOLW], 256, 256, PWT, -1, nullptr, scr, lane)) continue;
            if (transpose_mat<false>(r, a.in[I_POOLW] + 65536, 256, 256, PWT + 65536, -1, nullptr, scr, lane)) continue;
            if (transpose_mat<false>(r, a.in[I_POOLW] + 2 * 65536, 256, 256, PWT + 2 * 65536, -1, nullptr, scr, lane)) continue;
            transpose_mat<false>(r, a.in[I_POOLW] + 3 * 65536, 256, 256, PWT + 3 * 65536, -1, nullptr, scr, lane);
        }
        for (int i = bid * 512 + tid; i < 4 * 128 * 128; i += G * 512) { const int t = (i >> 7) & 127, s = i & 127; const float v = (s <= t) ? a.in[I_SGUW][i] : 0.f; SGW[i] = (bf16)(pk2(v, 0.f) & 0xffffu); }
        for (int i0 = bid * 512 + tid; i0 < M * DPLE / 8; i0 += 4 * G * 512) {
            f32x4 x0[4], x1[4];
#pragma unroll
            for (int j = 0; j < 4; ++j) { const int i = i0 + j * G * 512; if (i < M * DPLE / 8) { x0[j] = __builtin_nontemporal_load((const f32x4*)a.in[I_P] + 2 * i); x1[j] = __builtin_nontemporal_load((const f32x4*)a.in[I_P] + 2 * i + 1); } }
#pragma unroll
            for (int j = 0; j < 4; ++j) { const int i = i0 + j * G * 512; if (i < M * DPLE / 8) { v4u o; o.x = pk2(x0[j].x, x0[j].y); o.y = pk2(x0[j].z, x0[j].w); o.z = pk2(x1[j].x, x1[j].y); o.w = pk2(x1[j].z, x1[j].w); ((v4u*)PB)[i] = o; } }
        }
        x_rows_to_bf16(a.in[I_X], HB, RS, gw, NGW, lane);
    }
    SEAM(0);
    if (IN(1)) { pg8::Gemm g{XN, WGU1, M, 2 * FF, D}; pg8::StaticOrder S; S.init(M, 2 * FF, G, bid); EpiGU E{ACT, RS, lds}; rs_table_fill(lds, S, RS);
        pg8::gemm_phase<EpiGU, pg8::StaticOrder, ALIGN_GU, true, NT_WIDE, ZZ, PEELK>(lds, g, S, E); }
    SEAM(1);
    if (IN(2)) { pg8::Gemm g{ACT, WD1, M, D, FF}; pg8::StaticOrder S; S.init(M, D, G, bid); EpiN<0, false, false, true> E{FB, nullptr, nullptr, PART};
        pg8::gemm_phase<EpiN<0, false, false, true>, pg8::StaticOrder, true, true, NT_NARROW, ZZ, PEELK>(lds, g, S, E); }
    SEAM(2);
    if (IN(3)) ew_phase<false, false>(nullptr, HB, HB, nullptr, FB, PART, a.in[I_F1POST], 0.5f, RS, gw, NGW, lane);
    SEAM(3);
    if (IN(4)) { pg8::Gemm g{XN, WIN, M, DIN, D}; pg8::StaticOrder S; S.init(M, DIN, G, bid); EpiIn E{S1, RS, lds}; rs_table_fill(lds, S, RS);
        pg8::gemm_phase<EpiIn, pg8::StaticOrder, true, true, NT_WIDE, ZZ, PEELK>(lds, g, S, E); }
    SEAM(4);
    if (IN(5)) mixer_phase(lds, S1, S2, S3, BB, SGW, a.in[I_SGUB], a.in[I_SGUG], PWT, a.in[I_POOLS], G, bid);
    SEAM(5);
    if (IN(6)) {
        { pg8::Gemm g{S1, WOA, M, D, D}; pg8::StaticOrder S; S.init(M, D, G, bid); EpiN<0, true, false, false> E{S2, S4, nullptr, nullptr};
          pg8::gemm_phase<EpiN<0, true, false, false>, pg8::StaticOrder, true, true, NT_NARROW, ZZ, PEELK>(lds, g, S, E); }
        { pg8::Gemm g{BB, WOB, M, D, D}; pg8::StaticOrder S; S.init(M, D, G, bid); EpiN<0, true, true, false> E{S2, S5, S2, nullptr};
          pg8::gemm_phase<EpiN<0, true, true, false>, pg8::StaticOrder, true, true, NT_NARROW, ZZ, PEELK>(lds, g, S, E); }
    }
    SEAM(6);
    if (IN(7)) { pg8::Gemm g{S2, WO, M, D, D}; pg8::StaticOrder S; S.init(M, D, G, bid); EpiN<0, false, false, true> E{S3, nullptr, nullptr, PART};
        pg8::gemm_phase<EpiN<0, false, false, true>, pg8::StaticOrder, true, true, NT_NARROW, ZZ, PEELK>(lds, g, S, E); }
    SEAM(7);
    if (IN(8)) ew_phase<false, false>(nullptr, HB, HB, nullptr, S3, PART, a.in[I_MIXPOST], 1.0f, RS, gw, NGW, lane);
    SEAM(8);
    if (IN(9)) { pg8::Gemm g{XN, WGU2, M, 2 * FF, D}; pg8::StaticOrder S; S.init(M, 2 * FF, G, bid); EpiGU E{ACT, RS, lds}; rs_table_fill(lds, S, RS);
        pg8::gemm_phase<EpiGU, pg8::StaticOrder, ALIGN_GU, true, NT_WIDE, ZZ, PEELK>(lds, g, S, E); }
    SEAM(9);
    if (IN(10)) { pg8::Gemm g{ACT, WD2, M, D, FF}; pg8::StaticOrder S; S.init(M, D, G, bid); EpiN<0, false, false, true> E{FB, nullptr, nullptr, PART};
        pg8::gemm_phase<EpiN<0, false, false, true>, pg8::StaticOrder, true, true, NT_NARROW, ZZ, PEELK>(lds, g, S, E); }
    SEAM(10);
    if (IN(11)) ew_phase<false, false>(nullptr, HB, HB, nullptr, FB, PART, a.in[I_F2POST], 0.5f, RS, gw, NGW, lane);
    SEAM(11);
    if (IN(12)) {
        { pg8::Gemm g{XN, WPG, M, D, D}; pg8::StaticOrder S; S.init(M, D, G, bid); EpiN<1, false, false, false, true> E{S1, nullptr, nullptr, nullptr, RS, lds}; rs_table_fill(lds, S, RS);
          pg8::gemm_phase<EpiN<1, false, false, false, true>, pg8::StaticOrder, true, true, NT_NARROW, ZZ, PEELK>(lds, g, S, E); }
    }
    if (IN(13)) {
        { int kp = DPLE; asm volatile("" : "+s"(kp));
          pg8::Gemm g{PB, WPP, M, D, kp}; pg8::StaticOrder S; S.init(M, D, G, bid); EpiN<0, true, false, true> E{FB, S1, nullptr, PART};
          pg8::gemm_phase<EpiN<0, true, false, true>, pg8::StaticOrder, true, true, NT_NARROW, ZZ, PEELK>(lds, g, S, E); }
    }
    SEAM(13);
    if (IN(14)) ew_phase<false, true>(nullptr, HB, nullptr, a.out, FB, PART, a.in[I_PLEPOST], 1.0f, nullptr, gw, NGW, lane);
#undef IN
#undef SEAM
}

extern "C" void kernel_launch(void* const* d_in, const int* in_sizes, int n_in, void* d_out, int out_size, void* d_ws, size_t ws_size, hipStream_t stream) {
    static int grid = 0;
    if (grid == 0) {
        if (n_in != 27 || out_size != M * D || ws_size < WS_END) { fprintf(stderr, "kernel_launch: unexpected shapes (n_in %d out %d ws %zu)\n", n_in, out_size, ws_size); grid = -1; return; }
        int dev = 0, cus = 0, per_cu = 0;
        hipGetDevice(&dev); hipDeviceGetAttribute(&cus, hipDeviceAttributeMultiprocessorCount, dev);
        if (hipFuncSetAttribute((const void*)mk_fwd, hipFuncAttributeMaxDynamicSharedMemorySize, LDS_BYTES) != hipSuccess) { fprintf(stderr, "kernel_launch: hipFuncSetAttribute failed\n"); grid = -1; return; }
        if (hipOccupancyMaxActiveBlocksPerMultiprocessor(&per_cu, (const void*)mk_fwd, NWAVES * 64, LDS_BYTES) != hipSuccess || per_cu < 1) { fprintf(stderr, "kernel_launch: occupancy query says %d\n", per_cu); per_cu = 1; }
        (void)hipGetLastError();
        if (per_cu > 1) per_cu = 1;
        grid = cus * per_cu;
        if (grid <= 0) grid = 256;
    }
    if (grid < 0) return;
#ifdef DBG_MEMSET
    (void)hipMemsetAsync(d_ws, 0, WS_END, stream); (void)hipMemsetAsync(d_out, 0, (size_t)M * D * 4, stream);
#endif
    (void)hipMemsetAsync((char*)d_ws + WS_CTL, 0, CTL_BYTES, stream);
    Args a{};
    for (int i = 0; i < 27; ++i) a.in[i] = (const float*)d_in[i];
    a.out = (float*)d_out; a.ws = (unsigned char*)d_ws;
#if MK_N_LAUNCHES == 1
    a.ph_lo = 0; a.ph_hi = N_PHASES;
    void* args[] = {&a};
    hipError_t e = hipLaunchCooperativeKernel((void*)mk_fwd, dim3(grid), dim3(NWAVES * 64), args, LDS_BYTES, stream);
    if (e != hipSuccess) fprintf(stderr, "kernel_launch: cooperative launch failed: %s (grid %d)\n", hipGetErrorString(e), grid);
#else
    for (int p = 0; p < N_PHASES; ++p) for (int d = 0; d < NDUP(p); ++d) { a.ph_lo = p; a.ph_hi = p + 1; hipLaunchKernelGGL(mk_fwd, dim3(grid), dim3(NWAVES * 64), LDS_BYTES, stream, a); }
#endif
}
```
